# Optimizing an MI355X kernel written in HIP

```python
import jax, jax.numpy as jnp
from jax import lax
import numpy as np

D_MODEL = 1024
BATCH = 8
SEQ = 2048
DEPTH = 1

CHUNK = 64
D_MIX = D_MODEL
D_LRU = D_MIX // 2
LRU_BLOCKS = 8
LRU_BLOCK_DIM = D_LRU // LRU_BLOCKS
CONV_WIDTH = 4
LRU_C = 8.0
N_SB_HEADS = 8
SB_HEAD_DIM = 64
D_SB = N_SB_HEADS * SB_HEAD_DIM
Q_BLOCK = 128
D_IN_PROJ = 2 * D_LRU + 3 * D_SB
N_EXPERTS = 32
TOP_K = 4
D_EXPERT = D_MODEL
SWIGLU_LIMIT = 7.0
SWIGLU_ALPHA = 1.702
MOE_ROW_BLOCK = 256
D_PLE = 256
RMS_EPS = 1e-6

kernel_name = "hymba_rglru_stickbreak_moe_ple"


def rms_norm(x, g):
    xf = x.astype(jnp.float32)
    y = xf * lax.rsqrt(jnp.mean(xf * xf, axis=-1, keepdims=True) + RMS_EPS)
    return (y * g.astype(jnp.float32)).astype(x.dtype)


def causal_depthwise_conv(x, w, b):
    out = lax.conv_general_dilated(
        x, w[:, None, :], window_strides=(1,), padding=[(CONV_WIDTH - 1, 0)],
        dimension_numbers=("NWC", "WIO", "NWC"), feature_group_count=x.shape[-1])
    return out + b


def rg_lru(x, w_a, b_a, w_x, b_x, lam):
    B, S, C = x.shape
    xf = x.astype(jnp.float32)
    xb = xf.reshape(B, S, LRU_BLOCKS, LRU_BLOCK_DIM)
    r = jax.nn.sigmoid(jnp.einsum("bsni,nij->bsnj", xb, w_a.astype(jnp.float32)).reshape(B, S, C) + b_a)
    i = jax.nn.sigmoid(jnp.einsum("bsni,nij->bsnj", xb, w_x.astype(jnp.float32)).reshape(B, S, C) + b_x)
    log_a = -LRU_C * r * jax.nn.softplus(-lam.astype(jnp.float32))
    a = jnp.exp(log_a)
    b = jnp.sqrt(-jnp.expm1(2.0 * log_a)) * (i * xf)

    def combine(lhs, rhs):
        a1, b1 = lhs
        a2, b2 = rhs
        return a1 * a2, a2 * b1 + b2

    _, h = lax.associative_scan(combine, (a, b), axis=1)
    return h.astype(x.dtype)


def stick_breaking_attention(q, k, v):
    B, S, H, Dh = q.shape
    scale = SB_HEAD_DIM ** -0.5
    qf = q.astype(jnp.float32).transpose(0, 2, 1, 3)
    kf = k.astype(jnp.float32).transpose(0, 2, 1, 3)
    vf = v.astype(jnp.float32).transpose(0, 2, 1, 3)
    outs = []
    for blk in range(S // Q_BLOCK):
        q0 = blk * Q_BLOCK
        kv_len = q0 + Q_BLOCK
        z = jnp.einsum("bhqd,bhkd->bhqk", qf[:, :, q0:kv_len], kf[:, :, :kv_len]) * scale
        q_pos = q0 + jnp.arange(Q_BLOCK)
        k_pos = jnp.arange(kv_len)
        visible = k_pos[None, :] < q_pos[:, None]
        log_keep = jnp.where(visible, jax.nn.log_sigmoid(-z), 0.0)
        between = lax.cumsum(log_keep, axis=3, reverse=True) - log_keep
        weights = jnp.where(visible, jnp.exp(jax.nn.log_sigmoid(z) + between), 0.0)
        outs.append(jnp.einsum("bhqk,bhkd->bhqd", weights, vf[:, :, :kv_len]))
    o = jnp.concatenate(outs, axis=2)
    return o.transpose(0, 2, 1, 3).reshape(B, S, H * Dh).astype(q.dtype)


def moe_ffn(x, w_router, b_router, w_up, b_up, w_down, b_down):
    B, S, D = x.shape
    T = B * S
    xt = x.reshape(T, D)
    logits = (xt @ w_router + b_router).astype(jnp.float32)
    top_vals, top_idx = lax.top_k(logits, TOP_K)
    gates = jax.nn.softmax(top_vals, axis=-1).astype(x.dtype)

    n_assign = T * TOP_K
    expert_flat = top_idx.reshape(n_assign)
    token_flat = jnp.arange(n_assign, dtype=jnp.int32) // TOP_K
    gate_flat = gates.reshape(n_assign)
    order = jnp.argsort(expert_flat)
    sorted_expert = expert_flat[order]
    counts = jnp.zeros((N_EXPERTS,), jnp.int32).at[expert_flat].add(1)
    start = jnp.cumsum(counts) - counts
    padded = (counts + MOE_ROW_BLOCK - 1) // MOE_ROW_BLOCK * MOE_ROW_BLOCK
    padded_end = jnp.cumsum(padded)
    padded_start = padded_end - padded
    dest = padded_start[sorted_expert] + (jnp.arange(n_assign, dtype=jnp.int32) - start[sorted_expert])
    n_blocks = -(-n_assign // MOE_ROW_BLOCK) + N_EXPERTS
    n_rows = n_blocks * MOE_ROW_BLOCK
    row_token = jnp.zeros((n_rows,), jnp.int32).at[dest].set(token_flat[order])
    row_gate = jnp.zeros((n_rows,), x.dtype).at[dest].set(gate_flat[order])
    block_expert = jnp.clip(
        jnp.searchsorted(padded_end, jnp.arange(n_blocks, dtype=jnp.int32) * MOE_ROW_BLOCK, side="right"),
        0, N_EXPERTS - 1)

    def expert_block(args):
        e, tok = args
        xb = xt[tok]
        hdn = xb @ w_up[e] + b_up[e]
        g = jnp.minimum(hdn[:, :D_EXPERT], SWIGLU_LIMIT)
        u = jnp.clip(hdn[:, D_EXPERT:], -SWIGLU_LIMIT, SWIGLU_LIMIT)
        glu = g * jax.nn.sigmoid(SWIGLU_ALPHA * g)
        return ((u + 1.0) * glu) @ w_down[e] + b_down[e]

    y = lax.map(expert_block, (block_expert, row_token.reshape(n_blocks, MOE_ROW_BLOCK)))
    y = y.reshape(n_rows, D) * row_gate[:, None]
    out = jnp.zeros((T, D), x.dtype).at[row_token].add(y)
    return out.reshape(B, S, D)


def setup_inputs(seed: int = 0) -> dict:
    key = jax.random.key(seed)
    ks = jax.random.split(key, 26)

    def nrm(k, shape, scale):
        return jax.random.normal(k, shape, jnp.float32) * scale

    def gain(k, shape):
        return 1.0 + nrm(k, shape, 0.05)

    a0 = jax.random.uniform(ks[10], (DEPTH, D_LRU), jnp.float32, minval=0.9, maxval=0.999)
    return {
        "x": nrm(ks[0], (BATCH, SEQ, D_MODEL), 1.0),
        "p": nrm(ks[1], (DEPTH, BATCH, SEQ, D_PLE), 1.0),
        "mix_norm_g": gain(ks[2], (DEPTH, D_MODEL)),
        "w_in": nrm(ks[3], (DEPTH, D_MODEL, D_IN_PROJ), D_MODEL ** -0.5),
        "conv_w": nrm(ks[4], (DEPTH, CONV_WIDTH, D_LRU), CONV_WIDTH ** -0.5),
        "conv_b": nrm(ks[5], (DEPTH, D_LRU), 0.01),
        "lru_w_a": nrm(ks[6], (DEPTH, LRU_BLOCKS, LRU_BLOCK_DIM, LRU_BLOCK_DIM), LRU_BLOCK_DIM ** -0.5),
        "lru_b_a": nrm(ks[7], (DEPTH, D_LRU), 0.01),
        "lru_w_x": nrm(ks[8], (DEPTH, LRU_BLOCKS, LRU_BLOCK_DIM, LRU_BLOCK_DIM), LRU_BLOCK_DIM ** -0.5),
        "lru_b_x": nrm(ks[9], (DEPTH, D_LRU), 0.01),
        "lru_lambda": jnp.log(a0) - jnp.log1p(-a0),
        "lru_out_g": gain(ks[11], (DEPTH, D_LRU)),
        "sb_out_g": gain(ks[12], (DEPTH, D_SB)),
        "w_out": nrm(ks[13], (DEPTH, D_MIX, D_MODEL), D_MIX ** -0.5),
        "ffn_norm_g": gain(ks[14], (DEPTH, D_MODEL)),
        "w_router": nrm(ks[15], (DEPTH, D_MODEL, N_EXPERTS), D_MODEL ** -0.5),
        "b_router": nrm(ks[16], (DEPTH, N_EXPERTS), 0.01),
        "w_up": nrm(ks[17], (DEPTH, N_EXPERTS, D_MODEL, 2 * D_EXPERT), D_MODEL ** -0.5),
        "b_up": nrm(ks[18], (DEPTH, N_EXPERTS, 2 * D_EXPERT), 0.01),
        "w_down": nrm(ks[19], (DEPTH, N_EXPERTS, D_EXPERT, D_MODEL), D_EXPERT ** -0.5),
        "b_down": nrm(ks[20], (DEPTH, N_EXPERTS, D_MODEL), 0.01),
        "ple_norm_g": gain(ks[21], (DEPTH, D_MODEL)),
        "w_ple_gate": nrm(ks[22], (DEPTH, D_MODEL, D_MODEL), D_MODEL ** -0.5),
        "w_ple": nrm(ks[23], (DEPTH, D_PLE, D_MODEL), D_PLE ** -0.5),
        "final_norm_g": gain(ks[24], (D_MODEL,)),
    }


def reference(x, p, mix_norm_g, w_in, conv_w, conv_b, lru_w_a, lru_b_a, lru_w_x, lru_b_x,
              lru_lambda, lru_out_g, sb_out_g, w_out, ffn_norm_g, w_router, b_router,
              w_up, b_up, w_down, b_down, ple_norm_g, w_ple_gate, w_ple, final_norm_g):
    B, S, _ = x.shape
    h = x
    for i in range(DEPTH):
        xn = rms_norm(h, mix_norm_g[i])
        proj = xn @ w_in[i]
        lru_x, lru_gate, q, k, v = jnp.split(
            proj, [D_LRU, 2 * D_LRU, 2 * D_LRU + D_SB, 2 * D_LRU + 2 * D_SB], axis=-1)
        lru_h = rg_lru(causal_depthwise_conv(lru_x, conv_w[i], conv_b[i]),
                       lru_w_a[i], lru_b_a[i], lru_w_x[i], lru_b_x[i], lru_lambda[i])
        lru_y = lru_h * jax.nn.gelu(lru_gate)
        sb_y = stick_breaking_attention(q.reshape(B, S, N_SB_HEADS, SB_HEAD_DIM),
                                        k.reshape(B, S, N_SB_HEADS, SB_HEAD_DIM),
                                        v.reshape(B, S, N_SB_HEADS, SB_HEAD_DIM))
        mixed = jnp.concatenate([rms_norm(lru_y, lru_out_g[i]), rms_norm(sb_y, sb_out_g[i])], axis=-1)
        h = h + mixed @ w_out[i]
        h = h + moe_ffn(rms_norm(h, ffn_norm_g[i]), w_router[i], b_router[i],
                        w_up[i], b_up[i], w_down[i], b_down[i])
        ple = p[i] @ w_ple[i]
        ple_gate = jax.nn.sigmoid(rms_norm(h, ple_norm_g[i]) @ w_ple_gate[i])
        h = h + ple * ple_gate
    return rms_norm(h, final_norm_g)
```

```cpp
#include <hip/hip_runtime.h>
#include <cstdio>
#include <cstdint>

#ifndef MK_N_LAUNCHES
#define MK_N_LAUNCHES 1
#endif

constexpr int BATCH = 8, SEQ = 2048, DM = 1024, MTOK = BATCH * SEQ;
constexpr int DLRU = 512, DSB = 512, NPROJ = 2560, NEXP = 32, DEXP = 1024, DPLE = 256, NHEAD = 8, HD = 64;
constexpr int LCH = 64, NCHUNK = SEQ / LCH;
constexpr float RMS_EPS = 1e-6f;
constexpr int RPAD = MTOK * 4 + NEXP * 256;
constexpr int MAXTILES = RPAD / 256;

#define LAS __attribute__((address_space(3)))
#define GAS __attribute__((address_space(1)))
typedef unsigned short bf16_t;
typedef short bf16x8 __attribute__((ext_vector_type(8)));
typedef float f32x4 __attribute__((ext_vector_type(4)));
typedef float f32x2 __attribute__((ext_vector_type(2)));
typedef unsigned u32x4 __attribute__((ext_vector_type(4)));
typedef unsigned u32x2 __attribute__((ext_vector_type(2)));

__device__ __forceinline__ unsigned cvt_pk_bf16(float lo, float hi) { unsigned r; asm volatile("v_cvt_pk_bf16_f32 %0, %1, %2" : "=v"(r) : "v"(lo), "v"(hi)); return r; }
__device__ __forceinline__ float bf_lo(unsigned u) { return __uint_as_float(u << 16); }
__device__ __forceinline__ float bf_hi(unsigned u) { return __uint_as_float(u & 0xffff0000u); }
__device__ __forceinline__ float bf1(bf16_t v) { return __uint_as_float(((unsigned)v) << 16); }
__device__ __forceinline__ float wave_sum(float v) {
#pragma unroll
    for (int o = 1; o < 64; o <<= 1) v += __shfl_xor(v, o);
    return v;
}
__device__ __forceinline__ float sigmoidf_(float x) { return __builtin_amdgcn_rcpf(1.0f + __expf(-x)); }

namespace pg8 {
constexpr int BM = 256, BK = 64, HALF = 128, HTB = HALF * BK * 2, STAGE_BYTES = 8 * HTB, NXCD = 8, WGM = 8;
__host__ __device__ __forceinline__ int lds_byte(int r, int c) { const int st = (r >> 4) * 2 + (c >> 5), rr = r & 15, cc = c & 31, ob = rr * 64 + cc * 2; return st * 1024 + (ob ^ (((ob >> 9) & 1) << 5)); }
__host__ __device__ __forceinline__ void stage_rc(int b, int& R, int& C) { const int st = b / 1024, sb = b % 1024, swz = sb ^ (((sb >> 9) & 1) << 5); R = (st >> 1) * 16 + swz / 64; C = (st & 1) * 32 + (swz % 64) / 2; }
__host__ __device__ __forceinline__ int perm32(int rho) { const int n = rho >> 4, i = rho & 15; return 8 * (i >> 2) + 4 * n + (i & 3); }

struct Unit { int pm, pn, e; const char* A; const char* B; };

struct TileOrder {
    int nM, nN, nwg, G, c;
    __device__ __forceinline__ void init(int nM_, int nN_, int G_, int c_) { nM = nM_; nN = nN_; nwg = nM * nN; G = G_; c = c_; }
    __device__ __forceinline__ bool map(int i, int& pm, int& pn) const {
        const long L = (long)i * G + c; if (L >= nwg) return false;
        int wgid = (int)L; { const int q = nwg / NXCD, r = nwg % NXCD, xcd = wgid % NXCD, off = wgid / NXCD; wgid = (xcd < r ? xcd * (q + 1) : r * (q + 1) + (xcd - r) * q) + off; }
        const int nig = WGM * nN, gid = wgid / nig, fm = gid * WGM, gsz = (nM - fm) < WGM ? (nM - fm) : WGM;
        pm = fm + ((wgid % nig) % gsz); pn = (wgid % nig) / gsz; return true;
    }
};
struct DenseSched {
    TileOrder T; const char* A; const char* B; size_t tstep;
    __device__ __forceinline__ bool next(int i, Unit& u) const { if (!T.map(i, u.pm, u.pn)) return false; u.e = 0; u.A = A + (size_t)u.pm * tstep; u.B = B + (size_t)u.pn * tstep; return true; }
};
struct MoeSched {
    TileOrder T; const char* A; const char* B; size_t tstep, estride; const LAS int* tile_e;
    __device__ __forceinline__ bool next(int i, Unit& u) const { if (!T.map(i, u.pm, u.pn)) return false; u.e = __builtin_amdgcn_readfirstlane(tile_e[u.pm]);
        u.A = A + (size_t)u.pm * tstep; u.B = B + (size_t)u.e * estride + (size_t)u.pn * tstep; return true; }
};

template <class Epi, class Sched, bool ALIGN_EPI>
__device__ __forceinline__ void gemm_phase(LAS unsigned char* lds, const int K, const Sched& S, const Epi& E) {
    const int tid = threadIdx.x, wid = __builtin_amdgcn_readfirstlane(tid >> 6), lane = tid & 63, wr = wid >> 2, wc = wid & 3, fr = lane & 15, fq = lane >> 4;
    const int nt = K / BK;
    unsigned voffA[2], voffB[2];
#pragma unroll
    for (int i = 0; i < 2; ++i) { int R, C; stage_rc(tid * 16 + i * 8192, R, C); const int Rb = Epi::PERM ? ((R & ~31) + perm32(R & 31)) : R;
        voffA[i] = (unsigned)(R * K + C) * 2u; voffB[i] = (unsigned)(Rb * K + C) * 2u; }
    const size_t kstep = (size_t)(BK * 2);
    const size_t hstep = (size_t)HALF * K * 2;
    const unsigned ldsw = (unsigned)wid * 1024u;
    const int aoff = lds_byte(wr * 64 + fr, fq * 8), boff = lds_byte(wc * 32 + fr, fq * 8);
#define PG8_SA(b, h) (((b) * 2 + (h)) * HTB)
#define PG8_SB(b, h) ((4 + (b) * 2 + (h)) * HTB)
#define PG8_STAGE(bufoff, gbase, voff) do { _Pragma("unroll") for (int _i = 0; _i < 2; ++_i) \
        __builtin_amdgcn_global_load_lds((const unsigned*)((const char*)(gbase) + (voff)[_i]), (LAS unsigned*)(lds + (bufoff) + ldsw + _i * 8192), 16, 0, 0); } while (0)
#define PG8_LDA(dst, b, h) do { _Pragma("unroll") for (int m = 0; m < 4; ++m) _Pragma("unroll") for (int k = 0; k < 2; ++k) dst[m][k] = *(const LAS bf16x8*)(lds + PG8_SA(b, h) + aoff + m * 2048 + k * 1024); } while (0)
#define PG8_LDB(dst, b, h) do { _Pragma("unroll") for (int n = 0; n < 2; ++n) _Pragma("unroll") for (int k = 0; k < 2; ++k) dst[n][k] = *(const LAS bf16x8*)(lds + PG8_SB(b, h) + boff + n * 2048 + k * 1024); } while (0)
#define PG8_MMA(ai, bj, At, Bt) do { __builtin_amdgcn_s_setprio(1); _Pragma("unroll") for (int m = 0; m < 4; ++m) _Pragma("unroll") for (int n = 0; n < 2; ++n) _Pragma("unroll") for (int k = 0; k < 2; ++k) \
        acc[ai][bj][m][n] = __builtin_amdgcn_mfma_f32_16x16x32_bf16(Bt[n][k], At[m][k], acc[ai][bj][m][n], 0, 0, 0); __builtin_amdgcn_s_setprio(0); } while (0)
#define PG8_WAIT_V(n) asm volatile("s_waitcnt vmcnt(" #n ")" ::: "memory")
#define PG8_WAIT_L(n) asm volatile("s_waitcnt lgkmcnt(" #n ")" ::: "memory")
#define PG8_BAR __builtin_amdgcn_s_barrier()
#define PG8_SCHED __builtin_amdgcn_sched_barrier(0)
    Unit cur, nxt; int ui = 0;
    if (!S.next(0, cur)) return;
    f32x4 acc[2][2][4][2];
#pragma unroll
    for (int a = 0; a < 2; ++a)
#pragma unroll
        for (int b = 0; b < 2; ++b)
#pragma unroll
            for (int m = 0; m < 4; ++m)
#pragma unroll
                for (int n = 0; n < 2; ++n) acc[a][b][m][n] = (f32x4){0.f, 0.f, 0.f, 0.f};
    bf16x8 At[4][2], B0[2][2], B1[2][2];
    const char* cA = cur.A; const char* cB = cur.B;
    PG8_STAGE(PG8_SB(0, 0), cB, voffB); PG8_STAGE(PG8_SB(0, 1), cB + hstep, voffB); PG8_STAGE(PG8_SA(0, 0), cA, voffA); PG8_STAGE(PG8_SA(0, 1), cA + hstep, voffA);
    if (wr == 1) PG8_BAR;
    PG8_WAIT_V(2); PG8_BAR;
    PG8_STAGE(PG8_SB(1, 0), cB + kstep, voffB); PG8_STAGE(PG8_SA(1, 0), cA + kstep, voffA); PG8_STAGE(PG8_SB(1, 1), cB + hstep + kstep, voffB);
    PG8_WAIT_V(6); PG8_BAR;
    for (;;) {
        const bool has_next = S.next(ui + 1, nxt);
        const char* nA = has_next ? nxt.A : cA; const char* nB = has_next ? nxt.B : cB;
        for (int t = 0; t < nt; t += 2) {
            const bool last = (t == nt - 2);
            const char* a1 = cA + (size_t)(t + 1) * kstep;
            const char* a2 = last ? nA : cA + (size_t)(t + 2) * kstep; const char* b2 = last ? nB : cB + (size_t)(t + 2) * kstep;
            const char* a3 = a2 + kstep; const char* b3 = b2 + kstep;
            PG8_LDB(B0, 0, 0); PG8_LDB(B1, 0, 1); PG8_SCHED; PG8_LDA(At, 0, 0); PG8_STAGE(PG8_SA(1, 1), a1 + hstep, voffA);
            PG8_WAIT_V(8); PG8_WAIT_L(0); PG8_BAR; PG8_MMA(0, 0, At, B0); PG8_MMA(0, 1, At, B1); PG8_BAR; PG8_SCHED;
            PG8_LDA(At, 0, 1); PG8_STAGE(PG8_SB(0, 0), b2, voffB); PG8_STAGE(PG8_SB(0, 1), b2 + hstep, voffB); PG8_STAGE(PG8_SA(0, 0), a2, voffA);
            PG8_WAIT_V(8); PG8_WAIT_L(0); PG8_BAR; PG8_MMA(1, 0, At, B0); PG8_MMA(1, 1, At, B1); PG8_BAR; PG8_SCHED;
            PG8_LDB(B0, 1, 0); PG8_LDB(B1, 1, 1); PG8_SCHED; PG8_LDA(At, 1, 0); PG8_STAGE(PG8_SA(0, 1), a2 + hstep, voffA);
            PG8_WAIT_V(8); PG8_WAIT_L(0); PG8_BAR; PG8_MMA(0, 0, At, B0); PG8_MMA(0, 1, At, B1); PG8_BAR; PG8_SCHED;
            PG8_LDA(At, 1, 1); PG8_STAGE(PG8_SB(1, 0), b3, voffB); PG8_STAGE(PG8_SB(1, 1), b3 + hstep, voffB); PG8_STAGE(PG8_SA(1, 0), a3, voffA);
            PG8_WAIT_V(8); PG8_WAIT_L(0); PG8_BAR; PG8_MMA(1, 0, At, B0); PG8_MMA(1, 1, At, B1); PG8_BAR; PG8_SCHED;
        }
        if constexpr (ALIGN_EPI) { if (wr == 0) PG8_BAR; }
        E(acc, cur, wr, wc, fr, fq);
        if (!has_next) break;
#pragma unroll
        for (int a = 0; a < 2; ++a)
#pragma unroll
            for (int b = 0; b < 2; ++b)
#pragma unroll
                for (int m = 0; m < 4; ++m)
#pragma unroll
                    for (int n = 0; n < 2; ++n) acc[a][b][m][n] = (f32x4){0.f, 0.f, 0.f, 0.f};
        cur = nxt; cA = nA; cB = nB; ++ui;
        if constexpr (ALIGN_EPI) { if (wr == 1) PG8_BAR; }
    }
    PG8_WAIT_V(0);
    if constexpr (!ALIGN_EPI) { if (wr == 0) PG8_BAR; }
    PG8_BAR;
#undef PG8_SA
#undef PG8_SB
#undef PG8_STAGE
#undef PG8_LDA
#undef PG8_LDB
#undef PG8_MMA
#undef PG8_WAIT_V
#undef PG8_WAIT_L
#undef PG8_BAR
#undef PG8_SCHED
}

struct EpiBf16S {
    static constexpr bool PERM = true;
    bf16_t* O; int ldc; int spn_lo, spn_hi; float sc;
    __device__ __forceinline__ void operator()(const f32x4 (&acc)[2][2][4][2], const Unit& u, int wr, int wc, int fr, int fq) const {
        const int row0 = u.pm * BM + wr * 64 + fr, col0 = u.pn * BM + wc * 32 + 8 * fq;
        const float s = (u.pn >= spn_lo && u.pn < spn_hi) ? sc : 1.f;
#pragma unroll
        for (int ai = 0; ai < 2; ++ai)
#pragma unroll
            for (int m = 0; m < 4; ++m) { bf16_t* rowp = O + (size_t)(row0 + ai * HALF + m * 16) * ldc + col0;
#pragma unroll
                for (int bj = 0; bj < 2; ++bj) { const f32x4 v0 = acc[ai][bj][m][0] * s, v1 = acc[ai][bj][m][1] * s;
                    u32x4 w; w.x = cvt_pk_bf16(v0[0], v0[1]); w.y = cvt_pk_bf16(v0[2], v0[3]); w.z = cvt_pk_bf16(v1[0], v1[1]); w.w = cvt_pk_bf16(v1[2], v1[3]);
                    *(u32x4*)(rowp + bj * HALF) = w; } }
    }
};
struct EpiResF32 {
    static constexpr bool PERM = false;
    const float* base; float* out; int ldc;
    __device__ __forceinline__ void operator()(const f32x4 (&acc)[2][2][4][2], const Unit& u, int wr, int wc, int fr, int fq) const {
        const int row0 = u.pm * BM + wr * 64 + fr, col0 = u.pn * BM + wc * 32 + 4 * fq;
#pragma unroll
        for (int ai = 0; ai < 2; ++ai)
#pragma unroll
            for (int m = 0; m < 4; ++m) { const size_t off = (size_t)(row0 + ai * HALF + m * 16) * ldc + col0;
#pragma unroll
                for (int bj = 0; bj < 2; ++bj)
#pragma unroll
                    for (int n = 0; n < 2; ++n) { const f32x4 b = *(const f32x4*)(base + off + bj * HALF + n * 16); *(f32x4*)(out + off + bj * HALF + n * 16) = b + acc[ai][bj][m][n]; } }
    }
};
struct EpiUp {
    static constexpr bool PERM = true;
    bf16_t* ACT; const float* b_up;
    __device__ __forceinline__ void operator()(const f32x4 (&acc)[2][2][4][2], const Unit& u, int wr, int wc, int fr, int fq) const {
        const int row0 = u.pm * BM + wr * 64 + fr, oc0 = u.pn * HALF + wc * 32 + 8 * fq;
        const float* bg = b_up + (size_t)u.e * (2 * DEXP) + oc0; const float* bu = bg + DEXP;
        const f32x4 bg0 = *(const f32x4*)bg, bg1 = *(const f32x4*)(bg + 4), bu0 = *(const f32x4*)bu, bu1 = *(const f32x4*)(bu + 4);
#pragma unroll
        for (int ai = 0; ai < 2; ++ai)
#pragma unroll
            for (int m = 0; m < 4; ++m) { bf16_t* rowp = ACT + (size_t)(row0 + ai * HALF + m * 16) * DEXP + oc0;
                f32x4 g0 = acc[ai][0][m][0] + bg0, g1 = acc[ai][0][m][1] + bg1, u0 = acc[ai][1][m][0] + bu0, u1 = acc[ai][1][m][1] + bu1, r0, r1;
#pragma unroll
                for (int j = 0; j < 4; ++j) {
                    float g = fminf(g0[j], 7.0f), uu = fminf(fmaxf(u0[j], -7.0f), 7.0f); r0[j] = (uu + 1.0f) * g * sigmoidf_(1.702f * g);
                    g = fminf(g1[j], 7.0f); uu = fminf(fmaxf(u1[j], -7.0f), 7.0f); r1[j] = (uu + 1.0f) * g * sigmoidf_(1.702f * g); }
                u32x4 w; w.x = cvt_pk_bf16(r0[0], r0[1]); w.y = cvt_pk_bf16(r0[2], r0[3]); w.z = cvt_pk_bf16(r1[0], r1[1]); w.w = cvt_pk_bf16(r1[2], r1[3]);
                *(u32x4*)rowp = w; }
    }
};
struct EpiDown {
    static constexpr bool PERM = true;
    bf16_t* Y; const float* b_down; const float* row_gate;
    __device__ __forceinline__ void operator()(const f32x4 (&acc)[2][2][4][2], const Unit& u, int wr, int wc, int fr, int fq) const {
        const int row0 = u.pm * BM + wr * 64 + fr, col0 = u.pn * BM + wc * 32 + 8 * fq;
        const float* bb = b_down + (size_t)u.e * DM + col0;
        f32x4 bv[2][2];
#pragma unroll
        for (int bj = 0; bj < 2; ++bj)
#pragma unroll
            for (int n = 0; n < 2; ++n) bv[bj][n] = *(const f32x4*)(bb + bj * HALF + 4 * n);
#pragma unroll
        for (int ai = 0; ai < 2; ++ai)
#pragma unroll
            for (int m = 0; m < 4; ++m) { const int row = row0 + ai * HALF + m * 16; const float gt = row_gate[row]; bf16_t* rowp = Y + (size_t)row * DM + col0;
#pragma unroll
                for (int bj = 0; bj < 2; ++bj) { const f32x4 v0 = (acc[ai][bj][m][0] + bv[bj][0]) * gt, v1 = (acc[ai][bj][m][1] + bv[bj][1]) * gt;
                    u32x4 w; w.x = cvt_pk_bf16(v0[0], v0[1]); w.y = cvt_pk_bf16(v0[2], v0[3]); w.z = cvt_pk_bf16(v1[0], v1[1]); w.w = cvt_pk_bf16(v1[2], v1[3]);
                    *(u32x4*)(rowp + bj * HALF) = w; } }
    }
};
struct EpiPleGate {
    static constexpr bool PERM = false;
    float* io; const bf16_t* ple;
    __device__ __forceinline__ void operator()(const f32x4 (&acc)[2][2][4][2], const Unit& u, int wr, int wc, int fr, int fq) const {
        const int row0 = u.pm * BM + wr * 64 + fr, col0 = u.pn * BM + wc * 32 + 4 * fq;
#pragma unroll
        for (int ai = 0; ai < 2; ++ai)
#pragma unroll
            for (int m = 0; m < 4; ++m) { const size_t off = (size_t)(row0 + ai * HALF + m * 16) * DM + col0;
#pragma unroll
                for (int bj = 0; bj < 2; ++bj)
#pragma unroll
                    for (int n = 0; n < 2; ++n) { const size_t o = off + bj * HALF + n * 16; const f32x4 h = *(const f32x4*)(io + o); const u32x2 pp = *(const u32x2*)(ple + o);
                        const f32x4 a = acc[ai][bj][m][n]; f32x4 r;
                        r[0] = h[0] + bf_lo(pp.x) * sigmoidf_(a[0]); r[1] = h[1] + bf_hi(pp.x) * sigmoidf_(a[1]); r[2] = h[2] + bf_lo(pp.y) * sigmoidf_(a[2]); r[3] = h[3] + bf_hi(pp.y) * sigmoidf_(a[3]);
                        *(f32x4*)(io + o) = r; } }
    }
};
}

constexpr size_t MiB = 1u << 20;
constexpr size_t WS_CTL = 0, CTL_ZERO_BYTES = 1 * MiB;
constexpr size_t WS_AGG = 1 * MiB;
constexpr size_t WS_TOPI = 2 * MiB;
constexpr size_t WS_TOPG = WS_TOPI + 256 * 1024;
constexpr size_t WS_POS = WS_TOPG + 256 * 1024;
constexpr size_t WS_RGATE = WS_POS + 256 * 1024;
constexpr size_t WS_WIN = 4 * MiB;
constexpr size_t WS_WOUT = 9 * MiB;
constexpr size_t WS_WPG = 11 * MiB;
constexpr size_t WS_WPLE = 13 * MiB;
constexpr size_t WS_WUP = 16 * MiB;
constexpr size_t WS_WDN = 144 * MiB;
constexpr size_t WS_XN = 208 * MiB;
constexpr size_t WS_PB = 240 * MiB;
constexpr size_t WS_PROJ = 248 * MiB;
constexpr size_t WS_SBY = 328 * MiB;
constexpr size_t WS_MIX = 344 * MiB;
constexpr size_t WS_H1 = 376 * MiB;
constexpr size_t WS_HN = 440 * MiB;
constexpr size_t WS_PLE = 472 * MiB;
constexpr size_t WS_XS = 504 * MiB;
constexpr size_t WS_ACT = 648 * MiB;
constexpr size_t WS_Y = 208 * MiB;
constexpr size_t WS_HN2 = 792 * MiB;
constexpr size_t WS_AT = 824 * MiB;
constexpr size_t WS_BT = 856 * MiB;
constexpr size_t WS_END = 888 * MiB;
constexpr int CW_COUNTS = 64, CW_CURSOR = 128;
constexpr int CW_BAR = 4096;

constexpr int RING_OFF = 0, RING_BYTES = 131072;
constexpr int LDSCTL_OFF = RING_BYTES, MISC_OFF = LDSCTL_OFF + 320;
constexpr int SCR_OFF = RING_BYTES + 1024;
constexpr int LDS_BYTES = 147456;

typedef GAS unsigned gu32;
#define RLX_AGENT __ATOMIC_RELAXED, __HIP_MEMORY_SCOPE_AGENT
#define LDS_WAIT() asm volatile("s_waitcnt lgkmcnt(0)" ::: "memory")
#define VM_WAIT() asm volatile("s_waitcnt vmcnt(0)" ::: "memory")

#define XB_TMO      128
#define XB_XCNT(j)  (256  + 64 * (j))
#define XB_XSUB(j)  (1280 + 64 * (j))
#define XB_XGEN(j)  (2304 + 64 * (j))
#define XB_TOP      3328
#define XB_TOPGEN   3392
#define XCD_BAR_WORDS 3456
#define XB_SPIN_CAP (1u << 18)
__device__ __forceinline__ unsigned xb_ld(unsigned* p)              { return __hip_atomic_load(p, __ATOMIC_RELAXED, __HIP_MEMORY_SCOPE_AGENT); }
__device__ __forceinline__ unsigned xb_add(unsigned* p, unsigned v) { return __hip_atomic_fetch_add(p, v, __ATOMIC_RELAXED, __HIP_MEMORY_SCOPE_AGENT); }
__device__ __forceinline__ unsigned xb_xcc_id() { return (unsigned)__builtin_amdgcn_s_getreg((3 << 11) | 20) & 0xFu; }
#define XB_SPIN(cond, bar) do { unsigned _sp = 0; while (cond) { __builtin_amdgcn_s_sleep(1); \
    if ((++_sp & 255u) == 0u) { if (xb_ld(&(bar)[XB_TMO])) break; if (_sp > XB_SPIN_CAP) { atomicAdd(&(bar)[XB_TMO], 1u); break; } } } } while (0)
struct XcdBarrier { unsigned* bar; unsigned x; volatile LAS unsigned* st; };
__device__ __forceinline__ XcdBarrier xcd_barrier_post(unsigned* bar, volatile LAS unsigned* st) {
    XcdBarrier b; b.bar = bar; b.x = xb_xcc_id(); b.st = st;
    if (threadIdx.x == 0) (void)xb_add(&bar[XB_XCNT(b.x)], 1u);
    return b;
}
__device__ __forceinline__ void xcd_barrier_complete(unsigned* bar, unsigned x, unsigned& nloc, unsigned& nx) {
    const unsigned G = gridDim.x * gridDim.y * gridDim.z;
    unsigned sum, cnt, mine, sp = 0u;
    for (;;) {
        sum = 0u; cnt = 0u; mine = 0u;
#pragma unroll
        for (unsigned j = 0; j < 16; ++j) { const unsigned c = xb_ld(&bar[XB_XCNT(j)]); sum += c; cnt += (c > 0u) ? 1u : 0u; mine = (j == x) ? c : mine; }
        if (sum == G) break;
        __builtin_amdgcn_s_sleep(1);
        if ((++sp & 255u) == 0u) { if (xb_ld(&bar[XB_TMO])) break; if (sp > XB_SPIN_CAP) { atomicAdd(&bar[XB_TMO], 1u); break; } }
    }
    nloc = mine > 0u ? mine : 1u; nx = cnt > 0u ? cnt : 1u;
}
__device__ __forceinline__ void xcd_barrier(const XcdBarrier& b) {
    asm volatile("s_waitcnt vmcnt(0)" ::: "memory");
    __syncthreads();
    if (threadIdx.x == 0) {
        unsigned* bar = b.bar;
        __builtin_amdgcn_s_waitcnt(0);
        unsigned nloc = b.st[0], nx = b.st[1];
        if (nloc == 0u) { xcd_barrier_complete(bar, b.x, nloc, nx); b.st[0] = nloc; b.st[1] = nx; }
        const unsigned old = xb_add(&bar[XB_XSUB(b.x)], 1u);
        const unsigned gen = old / nloc;
        if (old + 1u == (gen + 1u) * nloc) {
            __builtin_amdgcn_fence(__ATOMIC_RELEASE, "agent");
            asm volatile("s_waitcnt vmcnt(0)" ::: "memory");
            const unsigned og = xb_add(&bar[XB_TOP], 1u);
            const unsigned tg = og / nx;
            if (og + 1u == (tg + 1u) * nx) xb_add(&bar[XB_TOPGEN], 1u);
            else XB_SPIN(xb_ld(&bar[XB_TOPGEN]) == tg, bar);
            __builtin_amdgcn_fence(__ATOMIC_ACQUIRE, "agent");
            xb_add(&bar[XB_XGEN(b.x)], 1u);
            asm volatile("s_waitcnt vmcnt(0)" ::: "memory");
        } else {
            XB_SPIN(xb_ld(&bar[XB_XGEN(b.x)]) == gen, bar);
            __builtin_amdgcn_fence(__ATOMIC_ACQUIRE, "agent");
            asm volatile("s_waitcnt vmcnt(0)" ::: "memory");
        }
    }
    __syncthreads();
}

struct Frame {
    LAS unsigned char* lds;
    volatile LAS unsigned* MISC;
    gu32* ctl;
    int tid, lane, wave, vcu, G;
    float* out; unsigned char* ws;
};
struct Args { const float* in[25]; float* out; unsigned char* ws; int ph_lo, ph_hi; };
typedef const float* const __attribute__((address_space(4)))* kin_t;
#define KIN_DECL kin_t inp = (kin_t)__builtin_amdgcn_kernarg_segment_ptr(); asm volatile("" : "+s"(inp)); unsigned char* wsb = F.ws; asm volatile("" : "+s"(wsb)); (void)wsb
enum { I_X = 0, I_P, I_MIXG, I_WIN, I_CONVW, I_CONVB, I_LWA, I_LBA, I_LWX, I_LBX, I_LAM, I_LOUTG, I_SBG, I_WOUT, I_FFNG, I_WR, I_BR, I_WUP, I_BUP, I_WDN, I_BDN, I_PLEG, I_WPG, I_WPLE, I_FING };

template <int MODE>
__device__ __forceinline__ void p0_transpose_item(const float* W, int K, int N, const float* ks, int ks_split, const float* ks2, bf16_t* WT, LAS float* scr, int item, int lane) {
    const int nblk = N / 32, kb = item / nblk, nb = item % nblk, k0 = 64 * kb, n0 = 32 * nb;
#pragma unroll 8
    for (int i = 0; i < 32; ++i) { const int kk = 2 * i + (lane >> 5); const int k = k0 + kk;
        float s = 1.f; if (ks) s = (k < ks_split) ? ks[k] : ks2[k - ks_split];
        scr[kk * 33 + (lane & 31)] = W[(size_t)k * N + n0 + (lane & 31)] * s; }
    LDS_WAIT(); asm volatile("" ::: "memory");
    const int c = lane & 7;
#pragma unroll
    for (int j = 0; j < 4; ++j) { const int n = (lane >> 3) + 8 * j; const LAS float* s = scr + (8 * c) * 33 + n;
        u32x4 o; o.x = cvt_pk_bf16(s[0 * 33], s[1 * 33]); o.y = cvt_pk_bf16(s[2 * 33], s[3 * 33]); o.z = cvt_pk_bf16(s[4 * 33], s[5 * 33]); o.w = cvt_pk_bf16(s[6 * 33], s[7 * 33]);
        const int nn = n0 + n; const int row = (MODE == 0) ? nn : (((nn & 1023) >> 7) * 256 + (nn >> 10) * 128 + (nn & 127));
        *(u32x4*)(WT + (size_t)row * K + k0 + 8 * c) = o; }
    LDS_WAIT(); asm volatile("" ::: "memory");
}
__device__ __forceinline__ void p0_prologue(Frame& F) {
    KIN_DECL;
    LAS float* scr = (LAS float*)(F.lds + RING_OFF + F.wave * 16384);
    const int gw = F.vcu * 8 + F.wave, NGW = F.G * 8;
    constexpr int I_IN = 16 * 80, I_OUT = 16 * 32, I_PG = 16 * 32, I_PLE = 4 * 32, I_UP1 = 16 * 64, I_DN1 = 16 * 32;
    constexpr int NSMALL = I_IN + I_OUT + I_PG + I_PLE, NITEMS = NSMALL + NEXP * (I_UP1 + I_DN1);
    for (int it = gw; it < NITEMS; it += NGW) {
        int r = it;
        if (r < I_IN) { p0_transpose_item<0>(inp[I_WIN], DM, NPROJ, inp[I_MIXG], DM, inp[I_MIXG], (bf16_t*)(wsb + WS_WIN), scr, r, F.lane); continue; } r -= I_IN;
        if (r < I_OUT) { p0_transpose_item<0>(inp[I_WOUT], DM, DM, inp[I_LOUTG], DLRU, inp[I_SBG], (bf16_t*)(wsb + WS_WOUT), scr, r, F.lane); continue; } r -= I_OUT;
        if (r < I_PG) { p0_transpose_item<0>(inp[I_WPG], DM, DM, inp[I_PLEG], DM, inp[I_PLEG], (bf16_t*)(wsb + WS_WPG), scr, r, F.lane); continue; } r -= I_PG;
        if (r < I_PLE) { p0_transpose_item<0>(inp[I_WPLE], DPLE, DM, nullptr, 0, nullptr, (bf16_t*)(wsb + WS_WPLE), scr, r, F.lane); continue; } r -= I_PLE;
        if (r < NEXP * I_UP1) { const int e = r / I_UP1;
            p0_transpose_item<1>(inp[I_WUP] + (size_t)e * DM * 2 * DEXP, DM, 2 * DEXP, inp[I_FFNG], DM, inp[I_FFNG], (bf16_t*)(wsb + WS_WUP) + (size_t)e * 2 * DEXP * DM, scr, r % I_UP1, F.lane); continue; }
        r -= NEXP * I_UP1;
        { const int e = r / I_DN1;
            p0_transpose_item<0>(inp[I_WDN] + (size_t)e * DEXP * DM, DEXP, DM, nullptr, 0, nullptr, (bf16_t*)(wsb + WS_WDN) + (size_t)e * DM * DEXP, scr, r % I_DN1, F.lane); }
    }
    const float* x = inp[I_X]; bf16_t* XN = (bf16_t*)(wsb + WS_XN);
    for (int m = gw; m < MTOK; m += NGW) {
        const f32x4* xr = (const f32x4*)(x + (size_t)m * DM) + F.lane; f32x4 v[4]; float s = 0.f;
#pragma unroll
        for (int j = 0; j < 4; ++j) { v[j] = xr[64 * j]; s += (v[j].x * v[j].x + v[j].y * v[j].y) + (v[j].z * v[j].z + v[j].w * v[j].w); }
        const float r = 1.0f / sqrtf(wave_sum(s) * (1.f / DM) + RMS_EPS);
        u32x2* o8 = (u32x2*)(XN + (size_t)m * DM) + F.lane;
#pragma unroll
        for (int j = 0; j < 4; ++j) { u32x2 w; w.x = cvt_pk_bf16(v[j].x * r, v[j].y * r); w.y = cvt_pk_bf16(v[j].z * r, v[j].w * r); o8[64 * j] = w; }
    }
    const float* p = inp[I_P]; bf16_t* PB = (bf16_t*)(wsb + WS_PB);
    const int nvec = MTOK * DPLE / 8;
    for (int i = gw * 64 + F.lane; i < nvec; i += NGW * 64) {
        const f32x4 a = *(const f32x4*)(p + (size_t)i * 8), b = *(const f32x4*)(p + (size_t)i * 8 + 4);
        u32x4 w; w.x = cvt_pk_bf16(a.x, a.y); w.y = cvt_pk_bf16(a.z, a.w); w.z = cvt_pk_bf16(b.x, b.y); w.w = cvt_pk_bf16(b.z, b.w);
        *(u32x4*)(PB + (size_t)i * 8) = w;
    }
}

__device__ __forceinline__ void attn_valu_phase(Frame& F) {
    KIN_DECL;
    const bf16_t* PROJ = (const bf16_t*)(wsb + WS_PROJ); bf16_t* SBY = (bf16_t*)(wsb + WS_SBY);
    LAS unsigned char* base = F.lds + RING_OFF + F.wave * 16384;
    LAS u32x4* Ks = (LAS u32x4*)base; LAS u32x4* Vs = (LAS u32x4*)(base + 8192);
    const int gw = F.vcu * 8 + F.wave, NGW = F.G * 8, lane = F.lane;
    for (int uidx = gw; uidx < BATCH * NHEAD * (SEQ / 64); uidx += NGW) {
        const int qt = (SEQ / 64 - 1) - uidx / (BATCH * NHEAD), bh = uidx % (BATCH * NHEAD), b = bh / NHEAD, h = bh % NHEAD;
        const int t = qt * 64 + lane; const size_t rowbase = (size_t)b * SEQ;
        float q[64], o[64];
        { const u32x4* qp = (const u32x4*)(PROJ + (rowbase + t) * NPROJ + 2 * DLRU + h * HD);
#pragma unroll
          for (int c = 0; c < 8; ++c) { const u32x4 w = qp[c]; q[8 * c + 0] = bf_lo(w.x); q[8 * c + 1] = bf_hi(w.x); q[8 * c + 2] = bf_lo(w.y); q[8 * c + 3] = bf_hi(w.y);
              q[8 * c + 4] = bf_lo(w.z); q[8 * c + 5] = bf_hi(w.z); q[8 * c + 6] = bf_lo(w.w); q[8 * c + 7] = bf_hi(w.w); } }
#pragma unroll
        for (int d = 0; d < 64; ++d) o[d] = 0.f;
        float cum = 0.f;
        for (int jt = qt; jt >= 0; --jt) {
            { const size_t kr = (rowbase + jt * 64 + lane) * NPROJ + 2 * DLRU + DSB + h * HD;
              const u32x4* kp = (const u32x4*)(PROJ + kr); const u32x4* vp = (const u32x4*)(PROJ + kr + DSB);
#pragma unroll
              for (int c = 0; c < 8; ++c) { Ks[lane * 8 + c] = kp[c]; Vs[lane * 8 + c] = vp[c]; } }
            LDS_WAIT(); asm volatile("" ::: "memory");
            for (int j = 63; j >= 0; --j) {
                const int kj = jt * 64 + j;
                float z = 0.f;
#pragma unroll
                for (int c = 0; c < 8; ++c) { const u32x4 w = Ks[j * 8 + c];
                    z += q[8 * c + 0] * bf_lo(w.x); z += q[8 * c + 1] * bf_hi(w.x); z += q[8 * c + 2] * bf_lo(w.y); z += q[8 * c + 3] * bf_hi(w.y);
                    z += q[8 * c + 4] * bf_lo(w.z); z += q[8 * c + 5] * bf_hi(w.z); z += q[8 * c + 6] * bf_lo(w.w); z += q[8 * c + 7] * bf_hi(w.w); }
                const bool vis = kj < t;
                const float L = log1pf(__expf(-fabsf(z)));
                const float ls_pos = fminf(z, 0.f) - L;
                const float ls_neg = fminf(-z, 0.f) - L;
                const float w = vis ? __expf(ls_pos + cum) : 0.f;
                cum += vis ? ls_neg : 0.f;
#pragma unroll
                for (int c = 0; c < 8; ++c) { const u32x4 vv = Vs[j * 8 + c];
                    o[8 * c + 0] += w * bf_lo(vv.x); o[8 * c + 1] += w * bf_hi(vv.x); o[8 * c + 2] += w * bf_lo(vv.y); o[8 * c + 3] += w * bf_hi(vv.y);
                    o[8 * c + 4] += w * bf_lo(vv.z); o[8 * c + 5] += w * bf_hi(vv.z); o[8 * c + 6] += w * bf_lo(vv.w); o[8 * c + 7] += w * bf_hi(vv.w); }
            }
            LDS_WAIT(); asm volatile("" ::: "memory");
        }
        u32x4* op = (u32x4*)(SBY + (rowbase + t) * DSB + h * HD);
#pragma unroll
        for (int c = 0; c < 8; ++c) { u32x4 w; w.x = cvt_pk_bf16(o[8 * c], o[8 * c + 1]); w.y = cvt_pk_bf16(o[8 * c + 2], o[8 * c + 3]); w.z = cvt_pk_bf16(o[8 * c + 4], o[8 * c + 5]); w.w = cvt_pk_bf16(o[8 * c + 6], o[8 * c + 7]); op[c] = w; }
    }
}

template <bool FINAL>
__device__ __forceinline__ void lru_units(Frame& F) {
    KIN_DECL;
    const bf16_t* PROJ = (const bf16_t*)(wsb + WS_PROJ);
    float* AGG_A = (float*)(wsb + WS_AGG); float* AGG_H = AGG_A + BATCH * NCHUNK * DLRU;
    float* AT = (float*)(wsb + WS_AT); float* BT = (float*)(wsb + WS_BT);
    LAS float* xs = (LAS float*)(F.lds + RING_OFF + F.wave * 16384);
    const int n = F.wave, j = F.lane, ch = n * 64 + j;
    for (int uidx = F.vcu; uidx < BATCH * NCHUNK; uidx += F.G) {
        const int b = uidx / NCHUNK, chunk = uidx % NCHUNK, t0 = chunk * LCH; const size_t rowbase = (size_t)b * SEQ;
        if (!FINAL) {
            const float cw0 = inp[I_CONVW][ch], cw1 = inp[I_CONVW][DLRU + ch], cw2 = inp[I_CONVW][2 * DLRU + ch], cw3 = inp[I_CONVW][3 * DLRU + ch], cb = inp[I_CONVB][ch];
            { float x3 = 0.f, x2 = 0.f, x1 = 0.f;
              if (chunk > 0) { const bf16_t* pp = PROJ + (rowbase + t0 - 3) * NPROJ + ch; x3 = bf1(pp[0]); x2 = bf1(pp[NPROJ]); x1 = bf1(pp[2 * NPROJ]); }
              const bf16_t* px = PROJ + (rowbase + t0) * NPROJ + ch;
#pragma unroll 8
              for (int tt = 0; tt < LCH; ++tt) { const float x0 = bf1(px[(size_t)tt * NPROJ]); xs[tt * 64 + j] = cb + cw0 * x3 + cw1 * x2 + cw2 * x1 + cw3 * x0; x3 = x2; x2 = x1; x1 = x0; } }
            LDS_WAIT(); asm volatile("" ::: "memory");
            float* at = AT + (rowbase + t0) * DLRU + ch; float* bt = BT + (rowbase + t0) * DLRU + ch;
            {
                float w[64]; const float* pa = inp[I_LWA] + (size_t)n * 4096 + j;
#pragma unroll
                for (int i = 0; i < 64; ++i) w[i] = pa[i * 64];
                const float ba = inp[I_LBA][ch]; const float sp8 = 8.0f * log1pf(__expf(-inp[I_LAM][ch]));
                for (int tt = 0; tt < LCH; ++tt) {
                    float rp = ba; const LAS f32x4* xr = (const LAS f32x4*)(xs + tt * 64);
#pragma unroll
                    for (int i4 = 0; i4 < 16; ++i4) { const f32x4 xv = xr[i4]; rp += xv.x * w[4 * i4] + xv.y * w[4 * i4 + 1] + xv.z * w[4 * i4 + 2] + xv.w * w[4 * i4 + 3]; }
                    at[(size_t)tt * DLRU] = -sp8 * sigmoidf_(rp);
                }
            }
            VM_WAIT(); asm volatile("" ::: "memory");
            {
                float w[64]; const float* px = inp[I_LWX] + (size_t)n * 4096 + j;
#pragma unroll
                for (int i = 0; i < 64; ++i) w[i] = px[i * 64];
                const float bx = inp[I_LBX][ch];
                float h = 0.f, A = 1.f;
#pragma unroll 4
                for (int tt = 0; tt < LCH; ++tt) {
                    float ip = bx; const LAS f32x4* xr = (const LAS f32x4*)(xs + tt * 64);
#pragma unroll
                    for (int i4 = 0; i4 < 16; ++i4) { const f32x4 xv = xr[i4]; ip += xv.x * w[4 * i4] + xv.y * w[4 * i4 + 1] + xv.z * w[4 * i4 + 2] + xv.w * w[4 * i4 + 3]; }
                    const float xown = xs[tt * 64 + j];
                    const float log_a = at[(size_t)tt * DLRU]; const float a = __expf(log_a);
                    const float bb = sqrtf(-expm1f(2.0f * log_a)) * (sigmoidf_(ip) * xown);
                    h = a * h + bb; A *= a;
                    at[(size_t)tt * DLRU] = a; bt[(size_t)tt * DLRU] = bb;
                }
                const size_t ai = ((size_t)b * NCHUNK + chunk) * DLRU + ch; AGG_A[ai] = A; AGG_H[ai] = h;
            }
            LDS_WAIT(); asm volatile("" ::: "memory");
        } else {
            float h = 0.f;
            for (int cc = 0; cc < chunk; ++cc) { const size_t ai = ((size_t)b * NCHUNK + cc) * DLRU + ch; h = AGG_A[ai] * h + AGG_H[ai]; }
            const bf16_t* pg = PROJ + (rowbase + t0) * NPROJ + DLRU + ch;
            const float* at = AT + (rowbase + t0) * DLRU + ch; const float* bt = BT + (rowbase + t0) * DLRU + ch;
#pragma unroll 8
            for (int tt = 0; tt < LCH; ++tt) {
                h = at[(size_t)tt * DLRU] * h + bt[(size_t)tt * DLRU];
                const float g = bf1(pg[(size_t)tt * NPROJ]); const float u = 0.7978845608f * (g + 0.044715f * g * g * g);
                const float th = 1.0f - 2.0f * __builtin_amdgcn_rcpf(__expf(2.0f * u) + 1.0f);
                xs[tt * 64 + j] = h * (0.5f * g * (1.0f + th));
            }
            LDS_WAIT(); __syncthreads();
            bf16_t* MIX = (bf16_t*)(wsb + WS_MIX); const bf16_t* SBY = (const bf16_t*)(wsb + WS_SBY);
            const int row = F.tid >> 3, seg = F.tid & 7; const size_t grow = rowbase + t0 + row;
            { const LAS f32x4* yr = (const LAS f32x4*)((LAS float*)(F.lds + RING_OFF + seg * 16384) + row * 64);
              float ss = 0.f;
#pragma unroll
              for (int i = 0; i < 16; ++i) { const f32x4 v = yr[i]; ss += (v.x * v.x + v.y * v.y) + (v.z * v.z + v.w * v.w); }
              ss += __shfl_xor(ss, 1); ss += __shfl_xor(ss, 2); ss += __shfl_xor(ss, 4);
              const float rs = 1.0f / sqrtf(ss * (1.f / DLRU) + RMS_EPS);
              u32x4* op = (u32x4*)(MIX + grow * DM + seg * 64);
#pragma unroll
              for (int i = 0; i < 8; ++i) { const f32x4 va = yr[2 * i], vb = yr[2 * i + 1]; u32x4 w; w.x = cvt_pk_bf16(va.x * rs, va.y * rs); w.y = cvt_pk_bf16(va.z * rs, va.w * rs);
                  w.z = cvt_pk_bf16(vb.x * rs, vb.y * rs); w.w = cvt_pk_bf16(vb.z * rs, vb.w * rs); op[i] = w; } }
            { const u32x4* sp = (const u32x4*)(SBY + grow * DSB + seg * 64); u32x4 v[8]; float ss = 0.f;
#pragma unroll
              for (int i = 0; i < 8; ++i) { v[i] = sp[i]; const float a0 = bf_lo(v[i].x), a1 = bf_hi(v[i].x), a2 = bf_lo(v[i].y), a3 = bf_hi(v[i].y), a4 = bf_lo(v[i].z), a5 = bf_hi(v[i].z), a6 = bf_lo(v[i].w), a7 = bf_hi(v[i].w);
                  ss += (a0 * a0 + a1 * a1) + (a2 * a2 + a3 * a3) + (a4 * a4 + a5 * a5) + (a6 * a6 + a7 * a7); }
              ss += __shfl_xor(ss, 1); ss += __shfl_xor(ss, 2); ss += __shfl_xor(ss, 4);
              const float rs = 1.0f / sqrtf(ss * (1.f / DSB) + RMS_EPS);
              u32x4* op = (u32x4*)(MIX + grow * DM + DLRU + seg * 64);
#pragma unroll
              for (int i = 0; i < 8; ++i) { u32x4 w; w.x = cvt_pk_bf16(bf_lo(v[i].x) * rs, bf_hi(v[i].x) * rs); w.y = cvt_pk_bf16(bf_lo(v[i].y) * rs, bf_hi(v[i].y) * rs);
                  w.z = cvt_pk_bf16(bf_lo(v[i].z) * rs, bf_hi(v[i].z) * rs); w.w = cvt_pk_bf16(bf_lo(v[i].w) * rs, bf_hi(v[i].w) * rs); op[i] = w; } }
            __syncthreads();
        }
    }
}

__device__ __forceinline__ void router_phase(Frame& F) {
    KIN_DECL;
    LAS float* WrT = (LAS float*)(F.lds + RING_OFF);
    LAS unsigned* hist = (LAS unsigned*)(F.lds + SCR_OFF);
    const float* wr = inp[I_WR]; const float* fg = inp[I_FFNG];
    for (int idx = F.tid; idx < DM * NEXP; idx += 512) { const int k = idx >> 5, e = idx & 31; WrT[e * DM + k] = wr[idx] * fg[k]; }
    if (F.tid < 32) hist[F.tid] = 0u;
    LDS_WAIT(); __syncthreads();
    const float* H1 = (const float*)(wsb + WS_H1); bf16_t* HN = (bf16_t*)(wsb + WS_HN);
    int* TOPI = (int*)(wsb + WS_TOPI); float* TOPG = (float*)(wsb + WS_TOPG);
    const int gw = F.vcu * 8 + F.wave, NGW = F.G * 8;
    for (int t = gw; t < MTOK; t += NGW) {
        const f32x4* xr = (const f32x4*)(H1 + (size_t)t * DM) + F.lane; f32x4 v[4]; float s = 0.f;
#pragma unroll
        for (int j = 0; j < 4; ++j) { v[j] = xr[64 * j]; s += (v[j].x * v[j].x + v[j].y * v[j].y) + (v[j].z * v[j].z + v[j].w * v[j].w); }
        const float r = 1.0f / sqrtf(wave_sum(s) * (1.f / DM) + RMS_EPS);
        u32x2* o8 = (u32x2*)(HN + (size_t)t * DM) + F.lane;
#pragma unroll
        for (int j = 0; j < 4; ++j) { u32x2 w; w.x = cvt_pk_bf16(v[j].x * r, v[j].y * r); w.y = cvt_pk_bf16(v[j].z * r, v[j].w * r); o8[64 * j] = w; }
        float lg[32];
#pragma unroll
        for (int e = 0; e < 32; ++e) { float a = 0.f;
#pragma unroll
            for (int j = 0; j < 4; ++j) { const f32x4 w = *(const LAS f32x4*)(WrT + e * DM + 256 * j + 4 * F.lane); a += (v[j].x * w.x + v[j].y * w.y) + (v[j].z * w.z + v[j].w * w.w); }
            lg[e] = a; }
#pragma unroll
        for (int e = 0; e < 32; ++e) lg[e] = wave_sum(lg[e]) * r + inp[I_BR][e];
        unsigned taken = 0u; int ti[4]; float tv[4];
#pragma unroll
        for (int k = 0; k < 4; ++k) { float best = -INFINITY; int bi = 0;
#pragma unroll
            for (int e = 0; e < 32; ++e) { const bool ok = !((taken >> e) & 1u) && (lg[e] > best); best = ok ? lg[e] : best; bi = ok ? e : bi; }
            taken |= 1u << bi; ti[k] = bi; tv[k] = best; }
        const float e1 = __expf(tv[1] - tv[0]), e2 = __expf(tv[2] - tv[0]), e3 = __expf(tv[3] - tv[0]); const float inv = 1.0f / (1.0f + e1 + e2 + e3);
        if (F.lane == 0) {
            *(int4*)(TOPI + (size_t)t * 4) = make_int4(ti[0], ti[1], ti[2], ti[3]);
            *(float4*)(TOPG + (size_t)t * 4) = make_float4(inv, e1 * inv, e2 * inv, e3 * inv);
            atomicAdd((unsigned*)&hist[ti[0]], 1u); atomicAdd((unsigned*)&hist[ti[1]], 1u); atomicAdd((unsigned*)&hist[ti[2]], 1u); atomicAdd((unsigned*)&hist[ti[3]], 1u);
        }
    }
    LDS_WAIT(); __syncthreads();
    if (F.tid < 32) { const unsigned c = hist[F.tid]; if (c) __hip_atomic_fetch_add((unsigned*)(F.ctl + CW_COUNTS + F.tid), c, RLX_AGENT); }
}

__device__ __forceinline__ int moe_segments(Frame& F, LAS int* seg, LAS int* tile_e) {
    if (F.tid == 0) { int acc = 0;
        for (int e = 0; e < NEXP; ++e) { seg[e] = acc; const int c = (int)__hip_atomic_load((unsigned*)(F.ctl + CW_COUNTS + e), RLX_AGENT); acc += ((c + 255) >> 8) << 8; }
        seg[NEXP] = acc; }
    LDS_WAIT(); __syncthreads();
    const int nt = seg[NEXP] >> 8;
    if (tile_e) { for (int tI = F.tid; tI < nt; tI += 512) { int e = 0;
#pragma unroll
            for (int k = 1; k < NEXP; ++k) e += (tI * 256 >= seg[k]) ? 1 : 0;
            tile_e[tI] = e; }
        LDS_WAIT(); __syncthreads(); }
    return nt;
}

__device__ __forceinline__ void dispatch_phase(Frame& F) {
    KIN_DECL;
    LAS int* seg = (LAS int*)(F.lds + SCR_OFF);
    LAS unsigned* hist = (LAS unsigned*)(F.lds + SCR_OFF + 256);
    LAS unsigned* gbase = (LAS unsigned*)(F.lds + SCR_OFF + 512);
    LAS int* lpos = (LAS int*)(F.lds + SCR_OFF + 1024);
    (void)moe_segments(F, seg, nullptr);
    const int* TOPI = (const int*)(wsb + WS_TOPI); const float* TOPG = (const float*)(wsb + WS_TOPG);
    int* POS = (int*)(wsb + WS_POS); float* RG = (float*)(wsb + WS_RGATE);
    const bf16_t* HN = (const bf16_t*)(wsb + WS_HN); bf16_t* XS = (bf16_t*)(wsb + WS_XS);
    for (int blk = F.vcu; blk < MTOK / 64; blk += F.G) {
        if (F.tid < 32) hist[F.tid] = 0u;
        LDS_WAIT(); __syncthreads();
        int e = 0; unsigned rank = 0;
        if (F.tid < 256) { e = TOPI[(size_t)blk * 256 + F.tid]; rank = atomicAdd((unsigned*)&hist[e], 1u); }
        LDS_WAIT(); __syncthreads();
        if (F.tid < 32) { const unsigned c = hist[F.tid]; gbase[F.tid] = c ? __hip_atomic_fetch_add((unsigned*)(F.ctl + CW_CURSOR + F.tid), c, RLX_AGENT) : 0u; }
        LDS_WAIT(); __syncthreads();
        if (F.tid < 256) { const int pos = seg[e] + (int)gbase[e] + (int)rank; lpos[F.tid] = pos; POS[(size_t)blk * 256 + F.tid] = pos; RG[pos] = TOPG[(size_t)blk * 256 + F.tid]; }
        LDS_WAIT(); __syncthreads();
        for (int a = F.wave; a < 256; a += 8) { const int pos = lpos[a]; const int t = blk * 64 + (a >> 2);
            const u32x4* src = (const u32x4*)(HN + (size_t)t * DM) + F.lane; u32x4* dst = (u32x4*)(XS + (size_t)pos * DM) + F.lane;
            const u32x4 v0 = src[0], v1 = src[64]; dst[0] = v0; dst[64] = v1; }
        __syncthreads();
    }
}

__device__ __forceinline__ void combine_phase(Frame& F) {
    KIN_DECL;
    const float* H1 = (const float*)(wsb + WS_H1); const bf16_t* Y = (const bf16_t*)(wsb + WS_Y); const int* POS = (const int*)(wsb + WS_POS);
    bf16_t* HN2 = (bf16_t*)(wsb + WS_HN2);
    const int gw = F.vcu * 8 + F.wave, NGW = F.G * 8;
    for (int t = gw; t < MTOK; t += NGW) {
        const int4 ps = *(const int4*)(POS + (size_t)t * 4);
        const f32x4* xr = (const f32x4*)(H1 + (size_t)t * DM) + F.lane; f32x4 v[4];
#pragma unroll
        for (int j = 0; j < 4; ++j) v[j] = xr[64 * j];
        const int pp[4] = {ps.x, ps.y, ps.z, ps.w};
#pragma unroll
        for (int k = 0; k < 4; ++k) { const u32x2* yr = (const u32x2*)(Y + (size_t)pp[k] * DM) + F.lane;
#pragma unroll
            for (int j = 0; j < 4; ++j) { const u32x2 w = yr[64 * j]; v[j].x += bf_lo(w.x); v[j].y += bf_hi(w.x); v[j].z += bf_lo(w.y); v[j].w += bf_hi(w.y); } }
        float s = 0.f;
#pragma unroll
        for (int j = 0; j < 4; ++j) s += (v[j].x * v[j].x + v[j].y * v[j].y) + (v[j].z * v[j].z + v[j].w * v[j].w);
        const float r = 1.0f / sqrtf(wave_sum(s) * (1.f / DM) + RMS_EPS);
        f32x4* orow = (f32x4*)(F.out + (size_t)t * DM) + F.lane; u32x2* o8 = (u32x2*)(HN2 + (size_t)t * DM) + F.lane;
#pragma unroll
        for (int j = 0; j < 4; ++j) { orow[64 * j] = v[j]; u32x2 w; w.x = cvt_pk_bf16(v[j].x * r, v[j].y * r); w.y = cvt_pk_bf16(v[j].z * r, v[j].w * r); o8[64 * j] = w; }
    }
}
__device__ __forceinline__ void final_phase(Frame& F) {
    KIN_DECL;
    const int gw = F.vcu * 8 + F.wave, NGW = F.G * 8; const float* g = inp[I_FING];
    f32x4 gv[4];
#pragma unroll
    for (int j = 0; j < 4; ++j) gv[j] = *((const f32x4*)g + F.lane + 64 * j);
    for (int t = gw; t < MTOK; t += NGW) {
        f32x4* xr = (f32x4*)(F.out + (size_t)t * DM) + F.lane; f32x4 v[4]; float s = 0.f;
#pragma unroll
        for (int j = 0; j < 4; ++j) { v[j] = xr[64 * j]; s += (v[j].x * v[j].x + v[j].y * v[j].y) + (v[j].z * v[j].z + v[j].w * v[j].w); }
        const float r = 1.0f / sqrtf(wave_sum(s) * (1.f / DM) + RMS_EPS);
#pragma unroll
        for (int j = 0; j < 4; ++j) xr[64 * j] = v[j] * r * gv[j];
    }
}

constexpr int N_PHASES = 12;
__global__ void __launch_bounds__(512, 2) mk_fwd(Args args) {
    extern __shared__ __attribute__((aligned(16))) unsigned char lds[];
    Frame F;
    F.lds = (LAS unsigned char*)lds;
    F.MISC = (volatile LAS unsigned*)(F.lds + MISC_OFF);
    F.tid = threadIdx.x; F.lane = F.tid & 63; F.wave = __builtin_amdgcn_readfirstlane(F.tid >> 6);
    F.G = gridDim.x; { const int bx = blockIdx.x; F.vcu = (F.G % 8 == 0) ? (bx % 8) * (F.G / 8) + bx / 8 : bx; }
    F.ws = args.ws; F.out = args.out; F.ctl = (gu32*)(args.ws + WS_CTL);
    for (int u = F.tid; u < (LDS_BYTES - LDSCTL_OFF) / 4; u += 512) ((LAS unsigned*)(F.lds + LDSCTL_OFF))[u] = 0u;
    __syncthreads();
    const int lo = args.ph_lo, hi = args.ph_hi;
    XcdBarrier bar; bar.bar = (unsigned*)(F.ctl + CW_BAR); bar.x = 0; bar.st = nullptr;
    if (hi - lo > 1) bar = xcd_barrier_post((unsigned*)(F.ctl + CW_BAR), F.MISC + 8);
#define IN(k) (lo <= (k) && (k) < hi)
#define SEAM(k) do { if (IN(k) && IN((k) + 1)) xcd_barrier(bar); } while (0)
    LAS unsigned char* ring = F.lds + RING_OFF;

    if (IN(0)) { p0_prologue(F); } SEAM(0);

    if (IN(1)) { KIN_DECL;
        { pg8::DenseSched S; S.T.init(MTOK / 256, NPROJ / 256, F.G, (int)blockIdx.x); S.A = (const char*)(wsb + WS_XN); S.B = (const char*)(wsb + WS_WIN); S.tstep = (size_t)256 * DM * 2;
          pg8::EpiBf16S E{(bf16_t*)(wsb + WS_PROJ), NPROJ, 4, 6, 0.125f};
          pg8::gemm_phase<pg8::EpiBf16S, pg8::DenseSched, true>(ring, DM, S, E); }
        { pg8::DenseSched S; S.T.init(MTOK / 256, DM / 256, F.G, (int)blockIdx.x); S.A = (const char*)(wsb + WS_PB); S.B = (const char*)(wsb + WS_WPLE); S.tstep = (size_t)256 * DPLE * 2;
          pg8::EpiBf16S E{(bf16_t*)(wsb + WS_PLE), DM, 0, 0, 1.f};
          pg8::gemm_phase<pg8::EpiBf16S, pg8::DenseSched, true>(ring, DPLE, S, E); }
    } SEAM(1);

    if (IN(2)) { attn_valu_phase(F); __syncthreads(); lru_units<false>(F); } SEAM(2);

    if (IN(3)) { lru_units<true>(F); } SEAM(3);

    if (IN(4)) { KIN_DECL;
        pg8::DenseSched S; S.T.init(MTOK / 256, DM / 256, F.G, (int)blockIdx.x); S.A = (const char*)(wsb + WS_MIX); S.B = (const char*)(wsb + WS_WOUT); S.tstep = (size_t)256 * DM * 2;
        pg8::EpiResF32 E{inp[I_X], (float*)(wsb + WS_H1), DM};
        pg8::gemm_phase<pg8::EpiResF32, pg8::DenseSched, false>(ring, DM, S, E);
    } SEAM(4);

    if (IN(5)) { router_phase(F); } SEAM(5);

    if (IN(6)) { dispatch_phase(F); } SEAM(6);

    if (IN(7)) { KIN_DECL;
        LAS int* seg = (LAS int*)(F.lds + SCR_OFF); LAS int* tile_e = (LAS int*)(F.lds + SCR_OFF + 2048);
        const int nt = moe_segments(F, seg, tile_e);
        pg8::MoeSched S; S.T.init(nt, 2 * DEXP / 256, F.G, (int)blockIdx.x); S.A = (const char*)(wsb + WS_XS); S.B = (const char*)(wsb + WS_WUP); S.tstep = (size_t)256 * DM * 2; S.estride = (size_t)2 * DEXP * DM * 2; S.tile_e = tile_e;
        pg8::EpiUp E{(bf16_t*)(wsb + WS_ACT), inp[I_BUP]};
        pg8::gemm_phase<pg8::EpiUp, pg8::MoeSched, true>(ring, DM, S, E);
    } SEAM(7);

    if (IN(8)) { KIN_DECL;
        LAS int* seg = (LAS int*)(F.lds + SCR_OFF); LAS int* tile_e = (LAS int*)(F.lds + SCR_OFF + 2048);
        const int nt = moe_segments(F, seg, tile_e);
        pg8::MoeSched S; S.T.init(nt, DM / 256, F.G, (int)blockIdx.x); S.A = (const char*)(wsb + WS_ACT); S.B = (const char*)(wsb + WS_WDN); S.tstep = (size_t)256 * DEXP * 2; S.estride = (size_t)DM * DEXP * 2; S.tile_e = tile_e;
        pg8::EpiDown E{(bf16_t*)(wsb + WS_Y), inp[I_BDN], (const float*)(wsb + WS_RGATE)};
        pg8::gemm_phase<pg8::EpiDown, pg8::MoeSched, true>(ring, DEXP, S, E);
    } SEAM(8);

    if (IN(9)) { combine_phase(F); } SEAM(9);

    if (IN(10)) { KIN_DECL;
        pg8::DenseSched S; S.T.init(MTOK / 256, DM / 256, F.G, (int)blockIdx.x); S.A = (const char*)(wsb + WS_HN2); S.B = (const char*)(wsb + WS_WPG); S.tstep = (size_t)256 * DM * 2;
        pg8::EpiPleGate E{F.out, (const bf16_t*)(wsb + WS_PLE)};
        pg8::gemm_phase<pg8::EpiPleGate, pg8::DenseSched, false>(ring, DM, S, E);
    } SEAM(10);

    if (IN(11)) { final_phase(F); }
#undef IN
#undef SEAM
}

extern "C" void kernel_launch(void* const* d_in, const int* in_sizes, int n_in, void* d_out, int out_size, void* d_ws, size_t ws_size, hipStream_t stream) {
    static int grid = 0;
    if (grid == 0) {
        if (n_in != 25 || in_sizes[0] != MTOK * DM || out_size != MTOK * DM || ws_size < WS_END) { fprintf(stderr, "kernel_launch: unexpected shapes (n_in %d, in0 %d, out %d, ws %zu)\n", n_in, n_in > 0 ? in_sizes[0] : -1, out_size, ws_size); grid = -1; return; }
        int dev = 0, cus = 0, per_cu = 0;
        if (hipGetDevice(&dev) != hipSuccess || hipDeviceGetAttribute(&cus, hipDeviceAttributeMultiprocessorCount, dev) != hipSuccess) { grid = -1; return; }
        if (hipFuncSetAttribute((const void*)mk_fwd, hipFuncAttributeMaxDynamicSharedMemorySize, LDS_BYTES) != hipSuccess) { fprintf(stderr, "kernel_launch: hipFuncSetAttribute failed\n"); grid = -1; return; }
        if (hipOccupancyMaxActiveBlocksPerMultiprocessor(&per_cu, (const void*)mk_fwd, 512, LDS_BYTES) != hipSuccess || per_cu < 1) { fprintf(stderr, "kernel_launch: occupancy query says %d blocks/CU\n", per_cu); (void)hipGetLastError(); grid = -1; return; }
        grid = cus;
    }
    if (grid < 0) return;
    (void)hipMemsetAsync((char*)d_ws + WS_CTL, 0, CTL_ZERO_BYTES, stream);
    Args a{};
    for (int i = 0; i < 25; ++i) a.in[i] = (const float*)d_in[i];
    a.out = (float*)d_out; a.ws = (unsigned char*)d_ws;
    if (MK_N_LAUNCHES == 1) { a.ph_lo = 0; a.ph_hi = N_PHASES; hipLaunchKernelGGL(mk_fwd, dim3(grid), dim3(512), LDS_BYTES, stream, a); }
    else for (int ph = 0; ph < N_PHASES; ++ph) { a.ph_lo = ph; a.ph_hi = ph + 1; hipLaunchKernelGGL(mk_fwd, dim3(grid), dim3(512), LDS_BYTES, stream, a); }
}
```

```cpp
#include <hip/hip_runtime.h>
#include <cstdio>
#include <cstdint>

#ifndef MK_N_LAUNCHES
#define MK_N_LAUNCHES 1
#endif

constexpr int BATCH = 8, SEQ = 2048, DM = 1024, MTOK = BATCH * SEQ;
constexpr int DLRU = 512, DSB = 512, NPROJ = 2560, NEXP = 32, DEXP = 1024, DPLE = 256, NHEAD = 8, HD = 64;
constexpr int LCH = 64, NCHUNK = SEQ / LCH;
constexpr float RMS_EPS = 1e-6f;
constexpr int RPAD = MTOK * 4 + NEXP * 256;
constexpr int MAXTILES = RPAD / 256;

#define LAS __attribute__((address_space(3)))
#define GAS __attribute__((address_space(1)))
typedef unsigned short bf16_t;
typedef short bf16x8 __attribute__((ext_vector_type(8)));
typedef float f32x4 __attribute__((ext_vector_type(4)));
typedef float f32x2 __attribute__((ext_vector_type(2)));
typedef unsigned u32x4 __attribute__((ext_vector_type(4)));
typedef unsigned u32x2 __attribute__((ext_vector_type(2)));

__device__ __forceinline__ unsigned cvt_pk_bf16(float lo, float hi) { unsigned r; asm volatile("v_cvt_pk_bf16_f32 %0, %1, %2" : "=v"(r) : "v"(lo), "v"(hi)); return r; }
__device__ __forceinline__ float bf_lo(unsigned u) { return __uint_as_float(u << 16); }
__device__ __forceinline__ float bf_hi(unsigned u) { return __uint_as_float(u & 0xffff0000u); }
__device__ __forceinline__ float bf1(bf16_t v) { return __uint_as_float(((unsigned)v) << 16); }
__device__ __forceinline__ float wave_sum(float v) {
#pragma unroll
    for (int o = 1; o < 64; o <<= 1) v += __shfl_xor(v, o);
    return v;
}
__device__ __forceinline__ float sigmoidf_(float x) { return __builtin_amdgcn_rcpf(1.0f + __expf(-x)); }

namespace pg8 {
constexpr int BM = 256, BK = 64, HALF = 128, HTB = HALF * BK * 2, STAGE_BYTES = 8 * HTB, NXCD = 8, WGM = 8;
__host__ __device__ __forceinline__ int lds_byte(int r, int c) { const int st = (r >> 4) * 2 + (c >> 5), rr = r & 15, cc = c & 31, ob = rr * 64 + cc * 2; return st * 1024 + (ob ^ (((ob >> 9) & 1) << 5)); }
__host__ __device__ __forceinline__ void stage_rc(int b, int& R, int& C) { const int st = b / 1024, sb = b % 1024, swz = sb ^ (((sb >> 9) & 1) << 5); R = (st >> 1) * 16 + swz / 64; C = (st & 1) * 32 + (swz % 64) / 2; }
__host__ __device__ __forceinline__ int perm32(int rho) { const int n = rho >> 4, i = rho & 15; return 8 * (i >> 2) + 4 * n + (i & 3); }

struct Unit { int pm, pn, e; const char* A; const char* B; };

struct TileOrder {
    int nM, nN, nwg, G, c;
    __device__ __forceinline__ void init(int nM_, int nN_, int G_, int c_) { nM = nM_; nN = nN_; nwg = nM * nN; G = G_; c = c_; }
    __device__ __forceinline__ bool map(int i, int& pm, int& pn) const {
        const long L = (long)i * G + c; if (L >= nwg) return false;
        int wgid = (int)L; { const int q = nwg / NXCD, r = nwg % NXCD, xcd = wgid % NXCD, off = wgid / NXCD; wgid = (xcd < r ? xcd * (q + 1) : r * (q + 1) + (xcd - r) * q) + off; }
        const int nig = WGM * nN, gid = wgid / nig, fm = gid * WGM, gsz = (nM - fm) < WGM ? (nM - fm) : WGM;
        pm = fm + ((wgid % nig) % gsz); pn = (wgid % nig) / gsz; return true;
    }
};
struct DenseSched {
    TileOrder T; const char* A; const char* B; size_t tstep;
    __device__ __forceinline__ bool next(int i, Unit& u) const { if (!T.map(i, u.pm, u.pn)) return false; u.e = 0; u.A = A + (size_t)u.pm * tstep; u.B = B + (size_t)u.pn * tstep; return true; }
};
struct MoeSched {
    TileOrder T; const char* A; const char* B; size_t tstep, estride; const LAS int* tile_e;
    __device__ __forceinline__ bool next(int i, Unit& u) const { if (!T.map(i, u.pm, u.pn)) return false; u.e = __builtin_amdgcn_readfirstlane(tile_e[u.pm]);
        u.A = A + (size_t)u.pm * tstep; u.B = B + (size_t)u.e * estride + (size_t)u.pn * tstep; return true; }
};

template <class Epi, class Sched, bool ALIGN_EPI>
__device__ __forceinline__ void gemm_phase(LAS unsigned char* lds, const int K, const Sched& S, const Epi& E) {
    const int tid = threadIdx.x, wid = __builtin_amdgcn_readfirstlane(tid >> 6), lane = tid & 63, wr = wid >> 2, wc = wid & 3, fr = lane & 15, fq = lane >> 4;
    const int nt = K / BK;
    unsigned voffA[2], voffB[2];
#pragma unroll
    for (int i = 0; i < 2; ++i) { int R, C; stage_rc(tid * 16 + i * 8192, R, C); const int Rb = Epi::PERM ? ((R & ~31) + perm32(R & 31)) : R;
        voffA[i] = (unsigned)(R * K + C) * 2u; voffB[i] = (unsigned)(Rb * K + C) * 2u; }
    const size_t kstep = (size_t)(BK * 2);
    const size_t hstep = (size_t)HALF * K * 2;
    const unsigned ldsw = (unsigned)wid * 1024u;
    const int aoff = lds_byte(wr * 64 + fr, fq * 8), boff = lds_byte(wc * 32 + fr, fq * 8);
#define PG8_SA(b, h) (((b) * 2 + (h)) * HTB)
#define PG8_SB(b, h) ((4 + (b) * 2 + (h)) * HTB)
#define PG8_STAGE(bufoff, gbase, voff) do { _Pragma("unroll") for (int _i = 0; _i < 2; ++_i) \
        __builtin_amdgcn_global_load_lds((const unsigned*)((const char*)(gbase) + (voff)[_i]), (LAS unsigned*)(lds + (bufoff) + ldsw + _i * 8192), 16, 0, 0); } while (0)
#define PG8_LDA(dst, b, h) do { _Pragma("unroll") for (int m = 0; m < 4; ++m) _Pragma("unroll") for (int k = 0; k < 2; ++k) dst[m][k] = *(const LAS bf16x8*)(lds + PG8_SA(b, h) + aoff + m * 2048 + k * 1024); } while (0)
#define PG8_LDB(dst, b, h) do { _Pragma("unroll") for (int n = 0; n < 2; ++n) _Pragma("unroll") for (int k = 0; k < 2; ++k) dst[n][k] = *(const LAS bf16x8*)(lds + PG8_SB(b, h) + boff + n * 2048 + k * 1024); } while (0)
#define PG8_MMA(ai, bj, At, Bt) do { __builtin_amdgcn_s_setprio(1); _Pragma("unroll") for (int m = 0; m < 4; ++m) _Pragma("unroll") for (int n = 0; n < 2; ++n) _Pragma("unroll") for (int k = 0; k < 2; ++k) \
        acc[ai][bj][m][n] = __builtin_amdgcn_mfma_f32_16x16x32_bf16(Bt[n][k], At[m][k], acc[ai][bj][m][n], 0, 0, 0); __builtin_amdgcn_s_setprio(0); } while (0)
#define PG8_WAIT_V(n) asm volatile("s_waitcnt vmcnt(" #n ")" ::: "memory")
#define PG8_WAIT_L(n) asm volatile("s_waitcnt lgkmcnt(" #n ")" ::: "memory")
#define PG8_BAR __builtin_amdgcn_s_barrier()
#define PG8_SCHED __builtin_amdgcn_sched_barrier(0)
    Unit cur, nxt; int ui = 0;
    if (!S.next(0, cur)) return;
    f32x4 acc[2][2][4][2];
#pragma unroll
    for (int a = 0; a < 2; ++a)
#pragma unroll
        for (int b = 0; b < 2; ++b)
#pragma unroll
            for (int m = 0; m < 4; ++m)
#pragma unroll
                for (int n = 0; n < 2; ++n) acc[a][b][m][n] = (f32x4){0.f, 0.f, 0.f, 0.f};
    bf16x8 At[4][2], B0[2][2], B1[2][2];
    const char* cA = cur.A; const char* cB = cur.B;
    PG8_STAGE(PG8_SB(0, 0), cB, voffB); PG8_STAGE(PG8_SB(0, 1), cB + hstep, voffB); PG8_STAGE(PG8_SA(0, 0), cA, voffA); PG8_STAGE(PG8_SA(0, 1), cA + hstep, voffA);
    if (wr == 1) PG8_BAR;
    PG8_WAIT_V(2); PG8_BAR;
    PG8_STAGE(PG8_SB(1, 0), cB + kstep, voffB); PG8_STAGE(PG8_SA(1, 0), cA + kstep, voffA); PG8_STAGE(PG8_SB(1, 1), cB + hstep + kstep, voffB);
    PG8_WAIT_V(6); PG8_BAR;
    for (;;) {
        const bool has_next = S.next(ui + 1, nxt);
        const char* nA = has_next ? nxt.A : cA; const char* nB = has_next ? nxt.B : cB;
        for (int t = 0; t < nt; t += 2) {
            const bool last = (t == nt - 2);
            const char* a1 = cA + (size_t)(t + 1) * kstep;
            const char* a2 = last ? nA : cA + (size_t)(t + 2) * kstep; const char* b2 = last ? nB : cB + (size_t)(t + 2) * kstep;
            const char* a3 = a2 + kstep; const char* b3 = b2 + kstep;
            PG8_LDB(B0, 0, 0); PG8_LDB(B1, 0, 1); PG8_SCHED; PG8_LDA(At, 0, 0); PG8_STAGE(PG8_SA(1, 1), a1 + hstep, voffA);
            PG8_WAIT_V(8); PG8_WAIT_L(0); PG8_BAR; PG8_MMA(0, 0, At, B0); PG8_MMA(0, 1, At, B1); PG8_BAR; PG8_SCHED;
            PG8_LDA(At, 0, 1); PG8_STAGE(PG8_SB(0, 0), b2, voffB); PG8_STAGE(PG8_SB(0, 1), b2 + hstep, voffB); PG8_STAGE(PG8_SA(0, 0), a2, voffA);
            PG8_WAIT_V(8); PG8_WAIT_L(0); PG8_BAR; PG8_MMA(1, 0, At, B0); PG8_MMA(1, 1, At, B1); PG8_BAR; PG8_SCHED;
            PG8_LDB(B0, 1, 0); PG8_LDB(B1, 1, 1); PG8_SCHED; PG8_LDA(At, 1, 0); PG8_STAGE(PG8_SA(0, 1), a2 + hstep, voffA);
            PG8_WAIT_V(8); PG8_WAIT_L(0); PG8_BAR; PG8_MMA(0, 0, At, B0); PG8_MMA(0, 1, At, B1); PG8_BAR; PG8_SCHED;
            PG8_LDA(At, 1, 1); PG8_STAGE(PG8_SB(1, 0), b3, voffB); PG8_STAGE(PG8_SB(1, 1), b3 + hstep, voffB); PG8_STAGE(PG8_SA(1, 0), a3, voffA);
            PG8_WAIT_V(8); PG8_WAIT_L(0); PG8_BAR; PG8_MMA(1, 0, At, B0); PG8_MMA(1, 1, At, B1); PG8_BAR; PG8_SCHED;
        }
        if constexpr (ALIGN_EPI) { if (wr == 0) PG8_BAR; }
        E(acc, cur, wr, wc, fr, fq);
        if (!has_next) break;
#pragma unroll
        for (int a = 0; a < 2; ++a)
#pragma unroll
            for (int b = 0; b < 2; ++b)
#pragma unroll
                for (int m = 0; m < 4; ++m)
#pragma unroll
                    for (int n = 0; n < 2; ++n) acc[a][b][m][n] = (f32x4){0.f, 0.f, 0.f, 0.f};
        cur = nxt; cA = nA; cB = nB; ++ui;
        if constexpr (ALIGN_EPI) { if (wr == 1) PG8_BAR; }
    }
    PG8_WAIT_V(0);
    if constexpr (!ALIGN_EPI) { if (wr == 0) PG8_BAR; }
    PG8_BAR;
#undef PG8_SA
#undef PG8_SB
#undef PG8_STAGE
#undef PG8_LDA
#undef PG8_LDB
#undef PG8_MMA
#undef PG8_WAIT_V
#undef PG8_WAIT_L
#undef PG8_BAR
#undef PG8_SCHED
}

struct EpiBf16S {
    static constexpr bool PERM = true;
    bf16_t* O; int ldc; int spn_lo, spn_hi; float sc;
    __device__ __forceinline__ void operator()(const f32x4 (&acc)[2][2][4][2], const Unit& u, int wr, int wc, int fr, int fq) const {
        const int row0 = u.pm * BM + wr * 64 + fr, col0 = u.pn * BM + wc * 32 + 8 * fq;
        const float s = (u.pn >= spn_lo && u.pn < spn_hi) ? sc : 1.f;
#pragma unroll
        for (int ai = 0; ai < 2; ++ai)
#pragma unroll
            for (int m = 0; m < 4; ++m) { bf16_t* rowp = O + (size_t)(row0 + ai * HALF + m * 16) * ldc + col0;
#pragma unroll
                for (int bj = 0; bj < 2; ++bj) { const f32x4 v0 = acc[ai][bj][m][0] * s, v1 = acc[ai][bj][m][1] * s;
                    u32x4 w; w.x = cvt_pk_bf16(v0[0], v0[1]); w.y = cvt_pk_bf16(v0[2], v0[3]); w.z = cvt_pk_bf16(v1[0], v1[1]); w.w = cvt_pk_bf16(v1[2], v1[3]);
                    *(u32x4*)(rowp + bj * HALF) = w; } }
    }
};
struct EpiResF32 {
    static constexpr bool PERM = false;
    const float* base; float* out; int ldc;
    __device__ __forceinline__ void operator()(const f32x4 (&acc)[2][2][4][2], const Unit& u, int wr, int wc, int fr, int fq) const {
        const int row0 = u.pm * BM + wr * 64 + fr, col0 = u.pn * BM + wc * 32 + 4 * fq;
#pragma unroll
        for (int ai = 0; ai < 2; ++ai)
#pragma unroll
            for (int m = 0; m < 4; ++m) { const size_t off = (size_t)(row0 + ai * HALF + m * 16) * ldc + col0;
#pragma unroll
                for (int bj = 0; bj < 2; ++bj)
#pragma unroll
                    for (int n = 0; n < 2; ++n) { const f32x4 b = *(const f32x4*)(base + off + bj * HALF + n * 16); *(f32x4*)(out + off + bj * HALF + n * 16) = b + acc[ai][bj][m][n]; } }
    }
};
struct EpiUp {
    static constexpr bool PERM = true;
    bf16_t* ACT; const float* b_up;
    __device__ __forceinline__ void operator()(const f32x4 (&acc)[2][2][4][2], const Unit& u, int wr, int wc, int fr, int fq) const {
        const int row0 = u.pm * BM + wr * 64 + fr, oc0 = u.pn * HALF + wc * 32 + 8 * fq;
        const float* bg = b_up + (size_t)u.e * (2 * DEXP) + oc0; const float* bu = bg + DEXP;
        const f32x4 bg0 = *(const f32x4*)bg, bg1 = *(const f32x4*)(bg + 4), bu0 = *(const f32x4*)bu, bu1 = *(const f32x4*)(bu + 4);
#pragma unroll
        for (int ai = 0; ai < 2; ++ai)
#pragma unroll
            for (int m = 0; m < 4; ++m) { bf16_t* rowp = ACT + (size_t)(row0 + ai * HALF + m * 16) * DEXP + oc0;
                f32x4 g0 = acc[ai][0][m][0] + bg0, g1 = acc[ai][0][m][1] + bg1, u0 = acc[ai][1][m][0] + bu0, u1 = acc[ai][1][m][1] + bu1, r0, r1;
#pragma unroll
                for (int j = 0; j < 4; ++j) {
                    float g = fminf(g0[j], 7.0f), uu = fminf(fmaxf(u0[j], -7.0f), 7.0f); r0[j] = (uu + 1.0f) * g * sigmoidf_(1.702f * g);
                    g = fminf(g1[j], 7.0f); uu = fminf(fmaxf(u1[j], -7.0f), 7.0f); r1[j] = (uu + 1.0f) * g * sigmoidf_(1.702f * g); }
                u32x4 w; w.x = cvt_pk_bf16(r0[0], r0[1]); w.y = cvt_pk_bf16(r0[2], r0[3]); w.z = cvt_pk_bf16(r1[0], r1[1]); w.w = cvt_pk_bf16(r1[2], r1[3]);
                *(u32x4*)rowp = w; }
    }
};
struct EpiDown {
    static constexpr bool PERM = true;
    bf16_t* Y; const float* b_down; const float* row_gate;
    __device__ __forceinline__ void operator()(const f32x4 (&acc)[2][2][4][2], const Unit& u, int wr, int wc, int fr, int fq) const {
        const int row0 = u.pm * BM + wr * 64 + fr, col0 = u.pn * BM + wc * 32 + 8 * fq;
        const float* bb = b_down + (size_t)u.e * DM + col0;
        f32x4 bv[2][2];
#pragma unroll
        for (int bj = 0; bj < 2; ++bj)
#pragma unroll
            for (int n = 0; n < 2; ++n) bv[bj][n] = *(const f32x4*)(bb + bj * HALF + 4 * n);
#pragma unroll
        for (int ai = 0; ai < 2; ++ai)
#pragma unroll
            for (int m = 0; m < 4; ++m) { const int row = row0 + ai * HALF + m * 16; const float gt = row_gate[row]; bf16_t* rowp = Y + (size_t)row * DM + col0;
#pragma unroll
                for (int bj = 0; bj < 2; ++bj) { const f32x4 v0 = (acc[ai][bj][m][0] + bv[bj][0]) * gt, v1 = (acc[ai][bj][m][1] + bv[bj][1]) * gt;
                    u32x4 w; w.x = cvt_pk_bf16(v0[0], v0[1]); w.y = cvt_pk_bf16(v0[2], v0[3]); w.z = cvt_pk_bf16(v1[0], v1[1]); w.w = cvt_pk_bf16(v1[2], v1[3]);
                    *(u32x4*)(rowp + bj * HALF) = w; } }
    }
};
struct EpiPleGate {
    static constexpr bool PERM = false;
    float* io; const bf16_t* ple;
    __device__ __forceinline__ void operator()(const f32x4 (&acc)[2][2][4][2], const Unit& u, int wr, int wc, int fr, int fq) const {
        const int row0 = u.pm * BM + wr * 64 + fr, col0 = u.pn * BM + wc * 32 + 4 * fq;
#pragma unroll
        for (int ai = 0; ai < 2; ++ai)
#pragma unroll
            for (int m = 0; m < 4; ++m) { const size_t off = (size_t)(row0 + ai * HALF + m * 16) * DM + col0;
#pragma unroll
                for (int bj = 0; bj < 2; ++bj)
#pragma unroll
                    for (int n = 0; n < 2; ++n) { const size_t o = off + bj * HALF + n * 16; const f32x4 h = *(const f32x4*)(io + o); const u32x2 pp = *(const u32x2*)(ple + o);
                        const f32x4 a = acc[ai][bj][m][n]; f32x4 r;
                        r[0] = h[0] + bf_lo(pp.x) * sigmoidf_(a[0]); r[1] = h[1] + bf_hi(pp.x) * sigmoidf_(a[1]); r[2] = h[2] + bf_lo(pp.y) * sigmoidf_(a[2]); r[3] = h[3] + bf_hi(pp.y) * sigmoidf_(a[3]);
                        *(f32x4*)(io + o) = r; } }
    }
};
}

constexpr size_t MiB = 1u << 20;
constexpr size_t WS_CTL = 0, CTL_ZERO_BYTES = 1 * MiB;
constexpr size_t WS_AGG = 1 * MiB;
constexpr size_t WS_TOPI = 2 * MiB;
constexpr size_t WS_TOPG = WS_TOPI + 256 * 1024;
constexpr size_t WS_POS = WS_TOPG + 256 * 1024;
constexpr size_t WS_RGATE = WS_POS + 256 * 1024;
constexpr size_t WS_WIN = 4 * MiB;
constexpr size_t WS_WOUT = 9 * MiB;
constexpr size_t WS_WPG = 11 * MiB;
constexpr size_t WS_WPLE = 13 * MiB;
constexpr size_t WS_WUP = 16 * MiB;
constexpr size_t WS_WDN = 144 * MiB;
constexpr size_t WS_XN = 208 * MiB;
constexpr size_t WS_PB = 240 * MiB;
constexpr size_t WS_PROJ = 248 * MiB;
constexpr size_t WS_SBY = 328 * MiB;
constexpr size_t WS_MIX = 344 * MiB;
constexpr size_t WS_H1 = 376 * MiB;
constexpr size_t WS_HN = 440 * MiB;
constexpr size_t WS_PLE = 472 * MiB;
constexpr size_t WS_XS = 504 * MiB;
constexpr size_t WS_ACT = 648 * MiB;
constexpr size_t WS_Y = 208 * MiB;
constexpr size_t WS_HN2 = 792 * MiB;
constexpr size_t WS_AT = 824 * MiB;
constexpr size_t WS_BT = 856 * MiB;
constexpr size_t WS_END = 888 * MiB;
constexpr int CW_COUNTS = 64, CW_CURSOR = 128;
constexpr int CW_BAR = 4096;

constexpr int RING_OFF = 0, RING_BYTES = 131072;
constexpr int LDSCTL_OFF = RING_BYTES, MISC_OFF = LDSCTL_OFF + 320;
constexpr int SCR_OFF = RING_BYTES + 1024;
constexpr int LDS_BYTES = 147456;

typedef GAS unsigned gu32;
#define RLX_AGENT __ATOMIC_RELAXED, __HIP_MEMORY_SCOPE_AGENT
#define LDS_WAIT() asm volatile("s_waitcnt lgkmcnt(0)" ::: "memory")
#define VM_WAIT() asm volatile("s_waitcnt vmcnt(0)" ::: "memory")

#define XB_TMO      128
#define XB_XCNT(j)  (256  + 64 * (j))
#define XB_XSUB(j)  (1280 + 64 * (j))
#define XB_XGEN(j)  (2304 + 64 * (j))
#define XB_TOP      3328
#define XB_TOPGEN   3392
#define XCD_BAR_WORDS 3456
#define XB_SPIN_CAP (1u << 18)
__device__ __forceinline__ unsigned xb_ld(unsigned* p)              { return __hip_atomic_load(p, __ATOMIC_RELAXED, __HIP_MEMORY_SCOPE_AGENT); }
__device__ __forceinline__ unsigned xb_add(unsigned* p, unsigned v) { return __hip_atomic_fetch_add(p, v, __ATOMIC_RELAXED, __HIP_MEMORY_SCOPE_AGENT); }
__device__ __forceinline__ unsigned xb_xcc_id() { return (unsigned)__builtin_amdgcn_s_getreg((3 << 11) | 20) & 0xFu; }
#define XB_SPIN(cond, bar) do { unsigned _sp = 0; while (cond) { __builtin_amdgcn_s_sleep(1); \
    if ((++_sp & 255u) == 0u) { if (xb_ld(&(bar)[XB_TMO])) break; if (_sp > XB_SPIN_CAP) { atomicAdd(&(bar)[XB_TMO], 1u); break; } } } } while (0)
struct XcdBarrier { unsigned* bar; unsigned x; volatile LAS unsigned* st; };
__device__ __forceinline__ XcdBarrier xcd_barrier_post(unsigned* bar, volatile LAS unsigned* st) {
    XcdBarrier b; b.bar = bar; b.x = xb_xcc_id(); b.st = st;
    if (threadIdx.x == 0) (void)xb_add(&bar[XB_XCNT(b.x)], 1u);
    return b;
}
__device__ __forceinline__ void xcd_barrier_complete(unsigned* bar, unsigned x, unsigned& nloc, unsigned& nx) {
    const unsigned G = gridDim.x * gridDim.y * gridDim.z;
    unsigned sum, cnt, mine, sp = 0u;
    for (;;) {
        sum = 0u; cnt = 0u; mine = 0u;
#pragma unroll
        for (unsigned j = 0; j < 16; ++j) { const unsigned c = xb_ld(&bar[XB_XCNT(j)]); sum += c; cnt += (c > 0u) ? 1u : 0u; mine = (j == x) ? c : mine; }
        if (sum == G) break;
        __builtin_amdgcn_s_sleep(1);
        if ((++sp & 255u) == 0u) { if (xb_ld(&bar[XB_TMO])) break; if (sp > XB_SPIN_CAP) { atomicAdd(&bar[XB_TMO], 1u); break; } }
    }
    nloc = mine > 0u ? mine : 1u; nx = cnt > 0u ? cnt : 1u;
}
__device__ __forceinline__ void xcd_barrier(const XcdBarrier& b) {
    asm volatile("s_waitcnt vmcnt(0)" ::: "memory");
    __syncthreads();
    if (threadIdx.x == 0) {
        unsigned* bar = b.bar;
        __builtin_amdgcn_s_waitcnt(0);
        unsigned nloc = b.st[0], nx = b.st[1];
        if (nloc == 0u) { xcd_barrier_complete(bar, b.x, nloc, nx); b.st[0] = nloc; b.st[1] = nx; }
        const unsigned old = xb_add(&bar[XB_XSUB(b.x)], 1u);
        const unsigned gen = old / nloc;
        if (old + 1u == (gen + 1u) * nloc) {
            __builtin_amdgcn_fence(__ATOMIC_RELEASE, "agent");
            asm volatile("s_waitcnt vmcnt(0)" ::: "memory");
            const unsigned og = xb_add(&bar[XB_TOP], 1u);
            const unsigned tg = og / nx;
            if (og + 1u == (tg + 1u) * nx) xb_add(&bar[XB_TOPGEN], 1u);
            else XB_SPIN(xb_ld(&bar[XB_TOPGEN]) == tg, bar);
            __builtin_amdgcn_fence(__ATOMIC_ACQUIRE, "agent");
            xb_add(&bar[XB_XGEN(b.x)], 1u);
            asm volatile("s_waitcnt vmcnt(0)" ::: "memory");
        } else {
            XB_SPIN(xb_ld(&bar[XB_XGEN(b.x)]) == gen, bar);
            __builtin_amdgcn_fence(__ATOMIC_ACQUIRE, "agent");
            asm volatile("s_waitcnt vmcnt(0)" ::: "memory");
        }
    }
    __syncthreads();
}

struct Frame {
    LAS unsigned char* lds;
    volatile LAS unsigned* MISC;
    gu32* ctl;
    int tid, lane, wave, vcu, G;
    float* out; unsigned char* ws;
};
struct Args { const float* in[25]; float* out; unsigned char* ws; int ph_lo, ph_hi; };
typedef const float* const __attribute__((address_space(4)))* kin_t;
#define KIN_DECL kin_t inp = (kin_t)__builtin_amdgcn_kernarg_segment_ptr(); asm volatile("" : "+s"(inp)); unsigned char* wsb = F.ws; asm volatile("" : "+s"(wsb)); (void)wsb
enum { I_X = 0, I_P, I_MIXG, I_WIN, I_CONVW, I_CONVB, I_LWA, I_LBA, I_LWX, I_LBX, I_LAM, I_LOUTG, I_SBG, I_WOUT, I_FFNG, I_WR, I_BR, I_WUP, I_BUP, I_WDN, I_BDN, I_PLEG, I_WPG, I_WPLE, I_FING };

template <int MODE>
__device__ __forceinline__ void p0_transpose_item(const float* W, int K, int N, const float* ks, int ks_split, const float* ks2, bf16_t* WT, LAS float* scr, int item, int lane) {
    const int nblk = N / 32, kb = item / nblk, nb = item % nblk, k0 = 64 * kb, n0 = 32 * nb;
#pragma unroll 8
    for (int i = 0; i < 32; ++i) { const int kk = 2 * i + (lane >> 5); const int k = k0 + kk;
        float s = 1.f; if (ks) s = (k < ks_split) ? ks[k] : ks2[k - ks_split];
        scr[kk * 33 + (lane & 31)] = W[(size_t)k * N + n0 + (lane & 31)] * s; }
    LDS_WAIT(); asm volatile("" ::: "memory");
    const int c = lane & 7;
#pragma unroll
    for (int j = 0; j < 4; ++j) { const int n = (lane >> 3) + 8 * j; const LAS float* s = scr + (8 * c) * 33 + n;
        u32x4 o; o.x = cvt_pk_bf16(s[0 * 33], s[1 * 33]); o.y = cvt_pk_bf16(s[2 * 33], s[3 * 33]); o.z = cvt_pk_bf16(s[4 * 33], s[5 * 33]); o.w = cvt_pk_bf16(s[6 * 33], s[7 * 33]);
        const int nn = n0 + n; const int row = (MODE == 0) ? nn : (((nn & 1023) >> 7) * 256 + (nn >> 10) * 128 + (nn & 127));
        *(u32x4*)(WT + (size_t)row * K + k0 + 8 * c) = o; }
    LDS_WAIT(); asm volatile("" ::: "memory");
}
__device__ __forceinline__ void p0_prologue(Frame& F) {
    KIN_DECL;
    LAS float* scr = (LAS float*)(F.lds + RING_OFF + F.wave * 16384);
    const int gw = F.vcu * 8 + F.wave, NGW = F.G * 8;
    constexpr int I_IN = 16 * 80, I_OUT = 16 * 32, I_PG = 16 * 32, I_PLE = 4 * 32, I_UP1 = 16 * 64, I_DN1 = 16 * 32;
    constexpr int NSMALL = I_IN + I_OUT + I_PG + I_PLE, NITEMS = NSMALL + NEXP * (I_UP1 + I_DN1);
    for (int it = gw; it < NITEMS; it += NGW) {
        int r = it;
        if (r < I_IN) { p0_transpose_item<0>(inp[I_WIN], DM, NPROJ, inp[I_MIXG], DM, inp[I_MIXG], (bf16_t*)(wsb + WS_WIN), scr, r, F.lane); continue; } r -= I_IN;
        if (r < I_OUT) { p0_transpose_item<0>(inp[I_WOUT], DM, DM, inp[I_LOUTG], DLRU, inp[I_SBG], (bf16_t*)(wsb + WS_WOUT), scr, r, F.lane); continue; } r -= I_OUT;
        if (r < I_PG) { p0_transpose_item<0>(inp[I_WPG], DM, DM, inp[I_PLEG], DM, inp[I_PLEG], (bf16_t*)(wsb + WS_WPG), scr, r, F.lane); continue; } r -= I_PG;
        if (r < I_PLE) { p0_transpose_item<0>(inp[I_WPLE], DPLE, DM, nullptr, 0, nullptr, (bf16_t*)(wsb + WS_WPLE), scr, r, F.lane); continue; } r -= I_PLE;
        if (r < NEXP * I_UP1) { const int e = r / I_UP1;
            p0_transpose_item<1>(inp[I_WUP] + (size_t)e * DM * 2 * DEXP, DM, 2 * DEXP, inp[I_FFNG], DM, inp[I_FFNG], (bf16_t*)(wsb + WS_WUP) + (size_t)e * 2 * DEXP * DM, scr, r % I_UP1, F.lane); continue; }
        r -= NEXP * I_UP1;
        { const int e = r / I_DN1;
            p0_transpose_item<0>(inp[I_WDN] + (size_t)e * DEXP * DM, DEXP, DM, nullptr, 0, nullptr, (bf16_t*)(wsb + WS_WDN) + (size_t)e * DM * DEXP, scr, r % I_DN1, F.lane); }
    }
    const float* x = inp[I_X]; bf16_t* XN = (bf16_t*)(wsb + WS_XN);
    for (int m = gw; m < MTOK; m += NGW) {
        const f32x4* xr = (const f32x4*)(x + (size_t)m * DM) + F.lane; f32x4 v[4]; float s = 0.f;
#pragma unroll
        for (int j = 0; j < 4; ++j) { v[j] = xr[64 * j]; s += (v[j].x * v[j].x + v[j].y * v[j].y) + (v[j].z * v[j].z + v[j].w * v[j].w); }
        const float r = 1.0f / sqrtf(wave_sum(s) * (1.f / DM) + RMS_EPS);
        u32x2* o8 = (u32x2*)(XN + (size_t)m * DM) + F.lane;
#pragma unroll
        for (int j = 0; j < 4; ++j) { u32x2 w; w.x = cvt_pk_bf16(v[j].x * r, v[j].y * r); w.y = cvt_pk_bf16(v[j].z * r, v[j].w * r); o8[64 * j] = w; }
    }
    const float* p = inp[I_P]; bf16_t* PB = (bf16_t*)(wsb + WS_PB);
    const int nvec = MTOK * DPLE / 8;
    for (int i = gw * 64 + F.lane; i < nvec; i += NGW * 64) {
        const f32x4 a = *(const f32x4*)(p + (size_t)i * 8), b = *(const f32x4*)(p + (size_t)i * 8 + 4);
        u32x4 w; w.x = cvt_pk_bf16(a.x, a.y); w.y = cvt_pk_bf16(a.z, a.w); w.z = cvt_pk_bf16(b.x, b.y); w.w = cvt_pk_bf16(b.z, b.w);
        *(u32x4*)(PB + (size_t)i * 8) = w;
    }
}

typedef float f32x16 __attribute__((ext_vector_type(16)));
typedef short v4i16_t __attribute__((ext_vector_type(4)));
#ifndef SB_EXIT_THR
#define SB_EXIT_THR 40.0f
#endif
__device__ __forceinline__ int crow(int r, int hi) { return (r & 3) + 8 * (r >> 2) + 4 * hi; }
__device__ __forceinline__ void attn_mfma_phase(Frame& F) {
    KIN_DECL;
    const bf16_t* PROJ = (const bf16_t*)(wsb + WS_PROJ); bf16_t* SBY = (bf16_t*)(wsb + WS_SBY);
    const int lane = F.lane, r32 = lane & 31, hl = lane >> 5;
    LAS unsigned char* wl = F.lds + RING_OFF + F.wave * 16384;
    const int vb = (4 * hl + ((lane & 15) >> 2)) * 128 + (16 * ((lane >> 4) & 1) + 4 * (lane & 3)) * 2;
    const int gw = F.vcu * 8 + F.wave, NGW = F.G * 8;
    constexpr int NU = BATCH * NHEAD * (SEQ / 32);
    for (int uidx = gw; uidx < NU; uidx += NGW) {
        const int half = uidx / (NU / 2), rem = uidx % (NU / 2), bh = half * (BATCH * NHEAD / 2) + rem / (SEQ / 32), qb = half ? (SEQ / 32 - 1) - rem % (SEQ / 32) : rem % (SEQ / 32);
        const int b = bh / NHEAD, h = bh % NHEAD; const size_t rowbase = (size_t)b * SEQ;
        bf16x8 qf[4];
        { const bf16_t* qrow = PROJ + (rowbase + qb * 32 + r32) * NPROJ + 2 * DLRU + h * HD + hl * 8;
#pragma unroll
          for (int s = 0; s < 4; ++s) qf[s] = *(const bf16x8*)(qrow + 16 * s); }
        const bf16_t* kbase = PROJ + rowbase * NPROJ + 2 * DLRU + DSB + h * HD; const bf16_t* vbase = kbase + DSB;
        f32x16 o0, o1;
#pragma unroll
        for (int r = 0; r < 16; ++r) { o0[r] = 0.f; o1[r] = 0.f; }
        float cum = 0.f;
        bf16x8 kn[4]; u32x4 vn[4];
        { const bf16_t* kr = kbase + (size_t)(qb * 32 + r32) * NPROJ + hl * 8;
#pragma unroll
          for (int s = 0; s < 4; ++s) kn[s] = *(const bf16x8*)(kr + 16 * s);
#pragma unroll
          for (int c = 0; c < 4; ++c) { const int idx = c * 64 + lane; vn[c] = *(const u32x4*)(vbase + (size_t)(qb * 32 + (idx >> 3)) * NPROJ + (idx & 7) * 8); } }
        for (int kt = qb; kt >= 0; --kt) {
            bf16x8 kf[4];
#pragma unroll
            for (int s = 0; s < 4; ++s) kf[s] = kn[s];
#pragma unroll
            for (int c = 0; c < 4; ++c) { const int idx = c * 64 + lane; *(LAS u32x4*)(wl + (idx >> 3) * 128 + (idx & 7) * 16) = vn[c]; }
            if (kt > 0) { const bf16_t* kr = kbase + (size_t)((kt - 1) * 32 + r32) * NPROJ + hl * 8;
#pragma unroll
                for (int s = 0; s < 4; ++s) kn[s] = *(const bf16x8*)(kr + 16 * s);
#pragma unroll
                for (int c = 0; c < 4; ++c) { const int idx = c * 64 + lane; vn[c] = *(const u32x4*)(vbase + (size_t)((kt - 1) * 32 + (idx >> 3)) * NPROJ + (idx & 7) * 8); } }
            f32x16 p;
#pragma unroll
            for (int r = 0; r < 16; ++r) p[r] = 0.f;
#pragma unroll
            for (int s = 0; s < 4; ++s) p = __builtin_amdgcn_mfma_f32_32x32x16_bf16(kf[s], qf[s], p, 0, 0, 0);
            float lk[16], lp[16];
            const bool diag = (kt == qb);
#pragma unroll
            for (int r = 0; r < 16; ++r) { const float z = p[r]; const float L = __logf(1.0f + __expf(-fabsf(z)));
                float sn = -(fmaxf(z, 0.f) + L); float sp = z + sn;
                if (diag) { const bool vis = crow(r, hl) < r32; sn = vis ? sn : 0.f; sp = vis ? sp : -INFINITY; }
                lk[r] = sn; lp[r] = sp; }
            const float G0 = (lk[0] + lk[1]) + (lk[2] + lk[3]), G1 = (lk[4] + lk[5]) + (lk[6] + lk[7]), G2 = (lk[8] + lk[9]) + (lk[10] + lk[11]), G3 = (lk[12] + lk[13]) + (lk[14] + lk[15]);
            const float P0 = __shfl_xor(G0, 32), P1 = __shfl_xor(G1, 32), P2 = __shfl_xor(G2, 32), P3 = __shfl_xor(G3, 32);
            float off[4];
            off[3] = cum + (hl == 0 ? P3 : 0.f);
            off[2] = cum + G3 + P3 + (hl == 0 ? P2 : 0.f);
            off[1] = cum + (G3 + G2) + (P3 + P2) + (hl == 0 ? P1 : 0.f);
            off[0] = cum + (G3 + G2 + G1) + (P3 + P2 + P1) + (hl == 0 ? P0 : 0.f);
            float w[16];
#pragma unroll
            for (int g = 0; g < 4; ++g) { float run = off[g];
#pragma unroll
                for (int e = 3; e >= 0; --e) { w[4 * g + e] = __expf(lp[4 * g + e] + run); run += lk[4 * g + e]; } }
            cum += (G0 + G1 + G2 + G3) + (P0 + P1 + P2 + P3);
            u32x4 pw0, pw1;
            pw0.x = cvt_pk_bf16(w[0], w[1]); pw0.y = cvt_pk_bf16(w[2], w[3]); pw0.z = cvt_pk_bf16(w[4], w[5]); pw0.w = cvt_pk_bf16(w[6], w[7]);
            pw1.x = cvt_pk_bf16(w[8], w[9]); pw1.y = cvt_pk_bf16(w[10], w[11]); pw1.z = cvt_pk_bf16(w[12], w[13]); pw1.w = cvt_pk_bf16(w[14], w[15]);
            const bf16x8 pa0 = __builtin_bit_cast(bf16x8, pw0), pa1 = __builtin_bit_cast(bf16x8, pw1);
#define SB_VTR(off_) __builtin_bit_cast(v4i16_t, __builtin_amdgcn_ds_read_tr16_b64_v4i16((LAS v4i16_t*)(wl + vb + (off_))))
#define SB_VFR(s_, d_) ({ const v4i16_t lo_ = SB_VTR((s_) * 2048 + (d_) * 64), hi_ = SB_VTR((s_) * 2048 + 1024 + (d_) * 64); (bf16x8){lo_[0], lo_[1], lo_[2], lo_[3], hi_[0], hi_[1], hi_[2], hi_[3]}; })
            { const bf16x8 v00 = SB_VFR(0, 0), v01 = SB_VFR(0, 1), v10 = SB_VFR(1, 0), v11 = SB_VFR(1, 1);
              o0 = __builtin_amdgcn_mfma_f32_32x32x16_bf16(pa0, v00, o0, 0, 0, 0); o1 = __builtin_amdgcn_mfma_f32_32x32x16_bf16(pa0, v01, o1, 0, 0, 0);
              o0 = __builtin_amdgcn_mfma_f32_32x32x16_bf16(pa1, v10, o0, 0, 0, 0); o1 = __builtin_amdgcn_mfma_f32_32x32x16_bf16(pa1, v11, o1, 0, 0, 0); }
#undef SB_VFR
#undef SB_VTR
            if (__all(cum < -SB_EXIT_THR)) break;
        }
        { LAS bf16_t* stg = (LAS bf16_t*)(wl + 8192);
#pragma unroll
          for (int r = 0; r < 16; ++r) { const int q = crow(r, hl); stg[q * 64 + r32] = (bf16_t)(cvt_pk_bf16(o0[r], 0.f) & 0xffffu); stg[q * 64 + 32 + r32] = (bf16_t)(cvt_pk_bf16(o1[r], 0.f) & 0xffffu); }
          LDS_WAIT(); asm volatile("" ::: "memory");
          bf16_t* orow = SBY + (rowbase + qb * 32) * DSB + h * HD;
#pragma unroll
          for (int i = 0; i < 4; ++i) { const int row = i * 8 + (lane >> 3), ch = lane & 7; const u32x4 v = *(const LAS u32x4*)(stg + row * 64 + ch * 8); *(u32x4*)(orow + (size_t)row * DSB + ch * 8) = v; }
          LDS_WAIT(); asm volatile("" ::: "memory"); }
    }
}

template <bool FINAL>
__device__ __forceinline__ void lru_units(Frame& F) {
    KIN_DECL;
    const bf16_t* PROJ = (const bf16_t*)(wsb + WS_PROJ);
    float* AGG_A = (float*)(wsb + WS_AGG); float* AGG_H = AGG_A + BATCH * NCHUNK * DLRU;
    float* AT = (float*)(wsb + WS_AT); float* BT = (float*)(wsb + WS_BT);
    LAS float* xs = (LAS float*)(F.lds + RING_OFF + F.wave * 16384);
    const int n = F.wave, j = F.lane, ch = n * 64 + j;
    for (int uidx = F.vcu; uidx < BATCH * NCHUNK; uidx += F.G) {
        const int b = uidx / NCHUNK, chunk = uidx % NCHUNK, t0 = chunk * LCH; const size_t rowbase = (size_t)b * SEQ;
        if (!FINAL) {
            const float cw0 = inp[I_CONVW][ch], cw1 = inp[I_CONVW][DLRU + ch], cw2 = inp[I_CONVW][2 * DLRU + ch], cw3 = inp[I_CONVW][3 * DLRU + ch], cb = inp[I_CONVB][ch];
            { float x3 = 0.f, x2 = 0.f, x1 = 0.f;
              if (chunk > 0) { const bf16_t* pp = PROJ + (rowbase + t0 - 3) * NPROJ + ch; x3 = bf1(pp[0]); x2 = bf1(pp[NPROJ]); x1 = bf1(pp[2 * NPROJ]); }
              const bf16_t* px = PROJ + (rowbase + t0) * NPROJ + ch;
#pragma unroll 8
              for (int tt = 0; tt < LCH; ++tt) { const float x0 = bf1(px[(size_t)tt * NPROJ]); xs[tt * 64 + j] = cb + cw0 * x3 + cw1 * x2 + cw2 * x1 + cw3 * x0; x3 = x2; x2 = x1; x1 = x0; } }
            LDS_WAIT(); asm volatile("" ::: "memory");
            float* at = AT + (rowbase + t0) * DLRU + ch; float* bt = BT + (rowbase + t0) * DLRU + ch;
            {
                float w[64]; const float* pa = inp[I_LWA] + (size_t)n * 4096 + j;
#pragma unroll
                for (int i = 0; i < 64; ++i) w[i] = pa[i * 64];
                const float ba = inp[I_LBA][ch]; const float sp8 = 8.0f * log1pf(__expf(-inp[I_LAM][ch]));
                for (int tt = 0; tt < LCH; ++tt) {
                    float rp = ba; const LAS f32x4* xr = (const LAS f32x4*)(xs + tt * 64);
#pragma unroll
                    for (int i4 = 0; i4 < 16; ++i4) { const f32x4 xv = xr[i4]; rp += xv.x * w[4 * i4] + xv.y * w[4 * i4 + 1] + xv.z * w[4 * i4 + 2] + xv.w * w[4 * i4 + 3]; }
                    at[(size_t)tt * DLRU] = -sp8 * sigmoidf_(rp);
                }
            }
            VM_WAIT(); asm volatile("" ::: "memory");
            {
                float w[64]; const float* px = inp[I_LWX] + (size_t)n * 4096 + j;
#pragma unroll
                for (int i = 0; i < 64; ++i) w[i] = px[i * 64];
                const float bx = inp[I_LBX][ch];
                float h = 0.f, A = 1.f;
#pragma unroll 4
                for (int tt = 0; tt < LCH; ++tt) {
                    float ip = bx; const LAS f32x4* xr = (const LAS f32x4*)(xs + tt * 64);
#pragma unroll
                    for (int i4 = 0; i4 < 16; ++i4) { const f32x4 xv = xr[i4]; ip += xv.x * w[4 * i4] + xv.y * w[4 * i4 + 1] + xv.z * w[4 * i4 + 2] + xv.w * w[4 * i4 + 3]; }
                    const float xown = xs[tt * 64 + j];
                    const float log_a = at[(size_t)tt * DLRU]; const float a = __expf(log_a);
                    const float bb = sqrtf(-expm1f(2.0f * log_a)) * (sigmoidf_(ip) * xown);
                    h = a * h + bb; A *= a;
                    at[(size_t)tt * DLRU] = a; bt[(size_t)tt * DLRU] = bb;
                }
                const size_t ai = ((size_t)b * NCHUNK + chunk) * DLRU + ch; AGG_A[ai] = A; AGG_H[ai] = h;
            }
            LDS_WAIT(); asm volatile("" ::: "memory");
        } else {
            float h = 0.f;
            for (int cc = 0; cc < chunk; ++cc) { const size_t ai = ((size_t)b * NCHUNK + cc) * DLRU + ch; h = AGG_A[ai] * h + AGG_H[ai]; }
            const bf16_t* pg = PROJ + (rowbase + t0) * NPROJ + DLRU + ch;
            const float* at = AT + (rowbase + t0) * DLRU + ch; const float* bt = BT + (rowbase + t0) * DLRU + ch;
#pragma unroll 8
            for (int tt = 0; tt < LCH; ++tt) {
                h = at[(size_t)tt * DLRU] * h + bt[(size_t)tt * DLRU];
                const float g = bf1(pg[(size_t)tt * NPROJ]); const float u = 0.7978845608f * (g + 0.044715f * g * g * g);
                const float th = 1.0f - 2.0f * __builtin_amdgcn_rcpf(__expf(2.0f * u) + 1.0f);
                xs[tt * 64 + j] = h * (0.5f * g * (1.0f + th));
            }
            LDS_WAIT(); __syncthreads();
            bf16_t* MIX = (bf16_t*)(wsb + WS_MIX); const bf16_t* SBY = (const bf16_t*)(wsb + WS_SBY);
            const int row = F.tid >> 3, seg = F.tid & 7; const size_t grow = rowbase + t0 + row;
            { const LAS f32x4* yr = (const LAS f32x4*)((LAS float*)(F.lds + RING_OFF + seg * 16384) + row * 64);
              float ss = 0.f;
#pragma unroll
              for (int i = 0; i < 16; ++i) { const f32x4 v = yr[i]; ss += (v.x * v.x + v.y * v.y) + (v.z * v.z + v.w * v.w); }
              ss += __shfl_xor(ss, 1); ss += __shfl_xor(ss, 2); ss += __shfl_xor(ss, 4);
              const float rs = 1.0f / sqrtf(ss * (1.f / DLRU) + RMS_EPS);
              u32x4* op = (u32x4*)(MIX + grow * DM + seg * 64);
#pragma unroll
              for (int i = 0; i < 8; ++i) { const f32x4 va = yr[2 * i], vb = yr[2 * i + 1]; u32x4 w; w.x = cvt_pk_bf16(va.x * rs, va.y * rs); w.y = cvt_pk_bf16(va.z * rs, va.w * rs);
                  w.z = cvt_pk_bf16(vb.x * rs, vb.y * rs); w.w = cvt_pk_bf16(vb.z * rs, vb.w * rs); op[i] = w; } }
            { const u32x4* sp = (const u32x4*)(SBY + grow * DSB + seg * 64); u32x4 v[8]; float ss = 0.f;
#pragma unroll
              for (int i = 0; i < 8; ++i) { v[i] = sp[i]; const float a0 = bf_lo(v[i].x), a1 = bf_hi(v[i].x), a2 = bf_lo(v[i].y), a3 = bf_hi(v[i].y), a4 = bf_lo(v[i].z), a5 = bf_hi(v[i].z), a6 = bf_lo(v[i].w), a7 = bf_hi(v[i].w);
                  ss += (a0 * a0 + a1 * a1) + (a2 * a2 + a3 * a3) + (a4 * a4 + a5 * a5) + (a6 * a6 + a7 * a7); }
              ss += __shfl_xor(ss, 1); ss += __shfl_xor(ss, 2); ss += __shfl_xor(ss, 4);
              const float rs = 1.0f / sqrtf(ss * (1.f / DSB) + RMS_EPS);
              u32x4* op = (u32x4*)(MIX + grow * DM + DLRU + seg * 64);
#pragma unroll
              for (int i = 0; i < 8; ++i) { u32x4 w; w.x = cvt_pk_bf16(bf_lo(v[i].x) * rs, bf_hi(v[i].x) * rs); w.y = cvt_pk_bf16(bf_lo(v[i].y) * rs, bf_hi(v[i].y) * rs);
                  w.z = cvt_pk_bf16(bf_lo(v[i].z) * rs, bf_hi(v[i].z) * rs); w.w = cvt_pk_bf16(bf_lo(v[i].w) * rs, bf_hi(v[i].w) * rs); op[i] = w; } }
            __syncthreads();
        }
    }
}

__device__ __forceinline__ void router_phase(Frame& F) {
    KIN_DECL;
    LAS float* WrT = (LAS float*)(F.lds + RING_OFF);
    LAS unsigned* hist = (LAS unsigned*)(F.lds + SCR_OFF);
    const float* wr = inp[I_WR]; const float* fg = inp[I_FFNG];
    for (int idx = F.tid; idx < DM * NEXP; idx += 512) { const int k = idx >> 5, e = idx & 31; WrT[e * DM + k] = wr[idx] * fg[k]; }
    if (F.tid < 32) hist[F.tid] = 0u;
    LDS_WAIT(); __syncthreads();
    const float* H1 = (const float*)(wsb + WS_H1); bf16_t* HN = (bf16_t*)(wsb + WS_HN);
    int* TOPI = (int*)(wsb + WS_TOPI); float* TOPG = (float*)(wsb + WS_TOPG);
    const int gw = F.vcu * 8 + F.wave, NGW = F.G * 8;
    for (int t = gw; t < MTOK; t += NGW) {
        const f32x4* xr = (const f32x4*)(H1 + (size_t)t * DM) + F.lane; f32x4 v[4]; float s = 0.f;
#pragma unroll
        for (int j = 0; j < 4; ++j) { v[j] = xr[64 * j]; s += (v[j].x * v[j].x + v[j].y * v[j].y) + (v[j].z * v[j].z + v[j].w * v[j].w); }
        const float r = 1.0f / sqrtf(wave_sum(s) * (1.f / DM) + RMS_EPS);
        u32x2* o8 = (u32x2*)(HN + (size_t)t * DM) + F.lane;
#pragma unroll
        for (int j = 0; j < 4; ++j) { u32x2 w; w.x = cvt_pk_bf16(v[j].x * r, v[j].y * r); w.y = cvt_pk_bf16(v[j].z * r, v[j].w * r); o8[64 * j] = w; }
        float lg[32];
#pragma unroll
        for (int e = 0; e < 32; ++e) { float a = 0.f;
#pragma unroll
            for (int j = 0; j < 4; ++j) { const f32x4 w = *(const LAS f32x4*)(WrT + e * DM + 256 * j + 4 * F.lane); a += (v[j].x * w.x + v[j].y * w.y) + (v[j].z * w.z + v[j].w * w.w); }
            lg[e] = a; }
#pragma unroll
        for (int e = 0; e < 32; ++e) lg[e] = wave_sum(lg[e]) * r + inp[I_BR][e];
        unsigned taken = 0u; int ti[4]; float tv[4];
#pragma unroll
        for (int k = 0; k < 4; ++k) { float best = -INFINITY; int bi = 0;
#pragma unroll
            for (int e = 0; e < 32; ++e) { const bool ok = !((taken >> e) & 1u) && (lg[e] > best); best = ok ? lg[e] : best; bi = ok ? e : bi; }
            taken |= 1u << bi; ti[k] = bi; tv[k] = best; }
        const float e1 = __expf(tv[1] - tv[0]), e2 = __expf(tv[2] - tv[0]), e3 = __expf(tv[3] - tv[0]); const float inv = 1.0f / (1.0f + e1 + e2 + e3);
        if (F.lane == 0) {
            *(int4*)(TOPI + (size_t)t * 4) = make_int4(ti[0], ti[1], ti[2], ti[3]);
            *(float4*)(TOPG + (size_t)t * 4) = make_float4(inv, e1 * inv, e2 * inv, e3 * inv);
            atomicAdd((unsigned*)&hist[ti[0]], 1u); atomicAdd((unsigned*)&hist[ti[1]], 1u); atomicAdd((unsigned*)&hist[ti[2]], 1u); atomicAdd((unsigned*)&hist[ti[3]], 1u);
        }
    }
    LDS_WAIT(); __syncthreads();
    if (F.tid < 32) { const unsigned c = hist[F.tid]; if (c) __hip_atomic_fetch_add((unsigned*)(F.ctl + CW_COUNTS + F.tid), c, RLX_AGENT); }
}

__device__ __forceinline__ int moe_segments(Frame& F, LAS int* seg, LAS int* tile_e) {
    if (F.tid == 0) { int acc = 0;
        for (int e = 0; e < NEXP; ++e) { seg[e] = acc; const int c = (int)__hip_atomic_load((unsigned*)(F.ctl + CW_COUNTS + e), RLX_AGENT); acc += ((c + 255) >> 8) << 8; }
        seg[NEXP] = acc; }
    LDS_WAIT(); __syncthreads();
    const int nt = seg[NEXP] >> 8;
    if (tile_e) { for (int tI = F.tid; tI < nt; tI += 512) { int e = 0;
#pragma unroll
            for (int k = 1; k < NEXP; ++k) e += (tI * 256 >= seg[k]) ? 1 : 0;
            tile_e[tI] = e; }
        LDS_WAIT(); __syncthreads(); }
    return nt;
}

__device__ __forceinline__ void dispatch_phase(Frame& F) {
    KIN_DECL;
    LAS int* seg = (LAS int*)(F.lds + SCR_OFF);
    LAS unsigned* hist = (LAS unsigned*)(F.lds + SCR_OFF + 256);
    LAS unsigned* gbase = (LAS unsigned*)(F.lds + SCR_OFF + 512);
    LAS int* lpos = (LAS int*)(F.lds + SCR_OFF + 1024);
    (void)moe_segments(F, seg, nullptr);
    const int* TOPI = (const int*)(wsb + WS_TOPI); const float* TOPG = (const float*)(wsb + WS_TOPG);
    int* POS = (int*)(wsb + WS_POS); float* RG = (float*)(wsb + WS_RGATE);
    const bf16_t* HN = (const bf16_t*)(wsb + WS_HN); bf16_t* XS = (bf16_t*)(wsb + WS_XS);
    for (int blk = F.vcu; blk < MTOK / 64; blk += F.G) {
        if (F.tid < 32) hist[F.tid] = 0u;
        LDS_WAIT(); __syncthreads();
        int e = 0; unsigned rank = 0;
        if (F.tid < 256) { e = TOPI[(size_t)blk * 256 + F.tid]; rank = atomicAdd((unsigned*)&hist[e], 1u); }
        LDS_WAIT(); __syncthreads();
        if (F.tid < 32) { const unsigned c = hist[F.tid]; gbase[F.tid] = c ? __hip_atomic_fetch_add((unsigned*)(F.ctl + CW_CURSOR + F.tid), c, RLX_AGENT) : 0u; }
        LDS_WAIT(); __syncthreads();
        if (F.tid < 256) { const int pos = seg[e] + (int)gbase[e] + (int)rank; lpos[F.tid] = pos; POS[(size_t)blk * 256 + F.tid] = pos; RG[pos] = TOPG[(size_t)blk * 256 + F.tid]; }
        LDS_WAIT(); __syncthreads();
        for (int a = F.wave; a < 256; a += 8) { const int pos = lpos[a]; const int t = blk * 64 + (a >> 2);
            const u32x4* src = (const u32x4*)(HN + (size_t)t * DM) + F.lane; u32x4* dst = (u32x4*)(XS + (size_t)pos * DM) + F.lane;
            const u32x4 v0 = src[0], v1 = src[64]; dst[0] = v0; dst[64] = v1; }
        __syncthreads();
    }
}

__device__ __forceinline__ void combine_phase(Frame& F) {
    KIN_DECL;
    const float* H1 = (const float*)(wsb + WS_H1); const bf16_t* Y = (const bf16_t*)(wsb + WS_Y); const int* POS = (const int*)(wsb + WS_POS);
    bf16_t* HN2 = (bf16_t*)(wsb + WS_HN2);
    const int gw = F.vcu * 8 + F.wave, NGW = F.G * 8;
    for (int t = gw; t < MTOK; t += NGW) {
        const int4 ps = *(const int4*)(POS + (size_t)t * 4);
        const f32x4* xr = (const f32x4*)(H1 + (size_t)t * DM) + F.lane; f32x4 v[4];
#pragma unroll
        for (int j = 0; j < 4; ++j) v[j] = xr[64 * j];
        const int pp[4] = {ps.x, ps.y, ps.z, ps.w};
#pragma unroll
        for (int k = 0; k < 4; ++k) { const u32x2* yr = (const u32x2*)(Y + (size_t)pp[k] * DM) + F.lane;
#pragma unroll
            for (int j = 0; j < 4; ++j) { const u32x2 w = yr[64 * j]; v[j].x += bf_lo(w.x); v[j].y += bf_hi(w.x); v[j].z += bf_lo(w.y); v[j].w += bf_hi(w.y); } }
        float s = 0.f;
#pragma unroll
        for (int j = 0; j < 4; ++j) s += (v[j].x * v[j].x + v[j].y * v[j].y) + (v[j].z * v[j].z + v[j].w * v[j].w);
        const float r = 1.0f / sqrtf(wave_sum(s) * (1.f / DM) + RMS_EPS);
        f32x4* orow = (f32x4*)(F.out + (size_t)t * DM) + F.lane; u32x2* o8 = (u32x2*)(HN2 + (size_t)t * DM) + F.lane;
#pragma unroll
        for (int j = 0; j < 4; ++j) { orow[64 * j] = v[j]; u32x2 w; w.x = cvt_pk_bf16(v[j].x * r, v[j].y * r); w.y = cvt_pk_bf16(v[j].z * r, v[j].w * r); o8[64 * j] = w; }
    }
}
__device__ __forceinline__ void final_phase(Frame& F) {
    KIN_DECL;
    const int gw = F.vcu * 8 + F.wave, NGW = F.G * 8; const float* g = inp[I_FING];
    f32x4 gv[4];
#pragma unroll
    for (int j = 0; j < 4; ++j) gv[j] = *((const f32x4*)g + F.lane + 64 * j);
    for (int t = gw; t < MTOK; t += NGW) {
        f32x4* xr = (f32x4*)(F.out + (size_t)t * DM) + F.lane; f32x4 v[4]; float s = 0.f;
#pragma unroll
        for (int j = 0; j < 4; ++j) { v[j] = xr[64 * j]; s += (v[j].x * v[j].x + v[j].y * v[j].y) + (v[j].z * v[j].z + v[j].w * v[j].w); }
        const float r = 1.0f / sqrtf(wave_sum(s) * (1.f / DM) + RMS_EPS);
#pragma unroll
        for (int j = 0; j < 4; ++j) xr[64 * j] = v[j] * r * gv[j];
    }
}

constexpr int N_PHASES = 12;
__global__ void __launch_bounds__(512, 2) mk_fwd(Args args) {
    extern __shared__ __attribute__((aligned(16))) unsigned char lds[];
    Frame F;
    F.lds = (LAS unsigned char*)lds;
    F.MISC = (volatile LAS unsigned*)(F.lds + MISC_OFF);
    F.tid = threadIdx.x; F.lane = F.tid & 63; F.wave = __builtin_amdgcn_readfirstlane(F.tid >> 6);
    F.G = gridDim.x; { const int bx = blockIdx.x; F.vcu = (F.G % 8 == 0) ? (bx % 8) * (F.G / 8) + bx / 8 : bx; }
    F.ws = args.ws; F.out = args.out; F.ctl = (gu32*)(args.ws + WS_CTL);
    for (int u = F.tid; u < (LDS_BYTES - LDSCTL_OFF) / 4; u += 512) ((LAS unsigned*)(F.lds + LDSCTL_OFF))[u] = 0u;
    __syncthreads();
    const int lo = args.ph_lo, hi = args.ph_hi;
    XcdBarrier bar; bar.bar = (unsigned*)(F.ctl + CW_BAR); bar.x = 0; bar.st = nullptr;
    if (hi - lo > 1) bar = xcd_barrier_post((unsigned*)(F.ctl + CW_BAR), F.MISC + 8);
#define IN(k) (lo <= (k) && (k) < hi)
#define SEAM(k) do { if (IN(k) && IN((k) + 1)) xcd_barrier(bar); } while (0)
    LAS unsigned char* ring = F.lds + RING_OFF;

    if (IN(0)) { p0_prologue(F); } SEAM(0);

    if (IN(1)) { KIN_DECL;
        { pg8::DenseSched S; S.T.init(MTOK / 256, NPROJ / 256, F.G, (int)blockIdx.x); S.A = (const char*)(wsb + WS_XN); S.B = (const char*)(wsb + WS_WIN); S.tstep = (size_t)256 * DM * 2;
          pg8::EpiBf16S E{(bf16_t*)(wsb + WS_PROJ), NPROJ, 4, 6, 0.125f};
          pg8::gemm_phase<pg8::EpiBf16S, pg8::DenseSched, true>(ring, DM, S, E); }
        { pg8::DenseSched S; S.T.init(MTOK / 256, DM / 256, F.G, (int)blockIdx.x); S.A = (const char*)(wsb + WS_PB); S.B = (const char*)(wsb + WS_WPLE); S.tstep = (size_t)256 * DPLE * 2;
          pg8::EpiBf16S E{(bf16_t*)(wsb + WS_PLE), DM, 0, 0, 1.f};
          pg8::gemm_phase<pg8::EpiBf16S, pg8::DenseSched, true>(ring, DPLE, S, E); }
    } SEAM(1);

    if (IN(2)) { attn_mfma_phase(F); __syncthreads(); lru_units<false>(F); } SEAM(2);

    if (IN(3)) { lru_units<true>(F); } SEAM(3);

    if (IN(4)) { KIN_DECL;
        pg8::DenseSched S; S.T.init(MTOK / 256, DM / 256, F.G, (int)blockIdx.x); S.A = (const char*)(wsb + WS_MIX); S.B = (const char*)(wsb + WS_WOUT); S.tstep = (size_t)256 * DM * 2;
        pg8::EpiResF32 E{inp[I_X], (float*)(wsb + WS_H1), DM};
        pg8::gemm_phase<pg8::EpiResF32, pg8::DenseSched, false>(ring, DM, S, E);
    } SEAM(4);

    if (IN(5)) { router_phase(F); } SEAM(5);

    if (IN(6)) { dispatch_phase(F); } SEAM(6);

    if (IN(7)) { KIN_DECL;
        LAS int* seg = (LAS int*)(F.lds + SCR_OFF); LAS int* tile_e = (LAS int*)(F.lds + SCR_OFF + 2048);
        const int nt = moe_segments(F, seg, tile_e);
        pg8::MoeSched S; S.T.init(nt, 2 * DEXP / 256, F.G, (int)blockIdx.x); S.A = (const char*)(wsb + WS_XS); S.B = (const char*)(wsb + WS_WUP); S.tstep = (size_t)256 * DM * 2; S.estride = (size_t)2 * DEXP * DM * 2; S.tile_e = tile_e;
        pg8::EpiUp E{(bf16_t*)(wsb + WS_ACT), inp[I_BUP]};
        pg8::gemm_phase<pg8::EpiUp, pg8::MoeSched, true>(ring, DM, S, E);
    } SEAM(7);

    if (IN(8)) { KIN_DECL;
        LAS int* seg = (LAS int*)(F.lds + SCR_OFF); LAS int* tile_e = (LAS int*)(F.lds + SCR_OFF + 2048);
        const int nt = moe_segments(F, seg, tile_e);
        pg8::MoeSched S; S.T.init(nt, DM / 256, F.G, (int)blockIdx.x); S.A = (const char*)(wsb + WS_ACT); S.B = (const char*)(wsb + WS_WDN); S.tstep = (size_t)256 * DEXP * 2; S.estride = (size_t)DM * DEXP * 2; S.tile_e = tile_e;
        pg8::EpiDown E{(bf16_t*)(wsb + WS_Y), inp[I_BDN], (const float*)(wsb + WS_RGATE)};
        pg8::gemm_phase<pg8::EpiDown, pg8::MoeSched, true>(ring, DEXP, S, E);
    } SEAM(8);

    if (IN(9)) { combine_phase(F); } SEAM(9);

    if (IN(10)) { KIN_DECL;
        pg8::DenseSched S; S.T.init(MTOK / 256, DM / 256, F.G, (int)blockIdx.x); S.A = (const char*)(wsb + WS_HN2); S.B = (const char*)(wsb + WS_WPG); S.tstep = (size_t)256 * DM * 2;
        pg8::EpiPleGate E{F.out, (const bf16_t*)(wsb + WS_PLE)};
        pg8::gemm_phase<pg8::EpiPleGate, pg8::DenseSched, false>(ring, DM, S, E);
    } SEAM(10);

    if (IN(11)) { final_phase(F); }
#undef IN
#undef SEAM
}

extern "C" void kernel_launch(void* const* d_in, const int* in_sizes, int n_in, void* d_out, int out_size, void* d_ws, size_t ws_size, hipStream_t stream) {
    static int grid = 0;
    if (grid == 0) {
        if (n_in != 25 || in_sizes[0] != MTOK * DM || out_size != MTOK * DM || ws_size < WS_END) { fprintf(stderr, "kernel_launch: unexpected shapes (n_in %d, in0 %d, out %d, ws %zu)\n", n_in, n_in > 0 ? in_sizes[0] : -1, out_size, ws_size); grid = -1; return; }
        int dev = 0, cus = 0, per_cu = 0;
        if (hipGetDevice(&dev) != hipSuccess || hipDeviceGetAttribute(&cus, hipDeviceAttributeMultiprocessorCount, dev) != hipSuccess) { grid = -1; return; }
        if (hipFuncSetAttribute((const void*)mk_fwd, hipFuncAttributeMaxDynamicSharedMemorySize, LDS_BYTES) != hipSuccess) { fprintf(stderr, "kernel_launch: hipFuncSetAttribute failed\n"); grid = -1; return; }
        if (hipOccupancyMaxActiveBlocksPerMultiprocessor(&per_cu, (const void*)mk_fwd, 512, LDS_BYTES) != hipSuccess || per_cu < 1) { fprintf(stderr, "kernel_launch: occupancy query says %d blocks/CU\n", per_cu); (void)hipGetLastError(); grid = -1; return; }
        grid = cus;
    }
    if (grid < 0) return;
    (void)hipMemsetAsync((char*)d_ws + WS_CTL, 0, CTL_ZERO_BYTES, stream);
    Args a{};
    for (int i = 0; i < 25; ++i) a.in[i] = (const float*)d_in[i];
    a.out = (float*)d_out; a.ws = (unsigned char*)d_ws;
    if (MK_N_LAUNCHES == 1) { a.ph_lo = 0; a.ph_hi = N_PHASES; hipLaunchKernelGGL(mk_fwd, dim3(grid), dim3(512), LDS_BYTES, stream, a); }
    else for (int ph = 0; ph < N_PHASES; ++ph) { a.ph_lo = ph; a.ph_hi = ph + 1; hipLaunchKernelGGL(mk_fwd, dim3(grid), dim3(512), LDS_BYTES, stream, a); }
}
```
